# Optimizing an MI355X kernel written in HIP

```python
import math
import jax, jax.numpy as jnp
from jax import lax
import numpy as np


D_MODEL = 1024
BATCH = 8
SEQ = 2048
DEPTH = 1

CHUNK = 64
Q_BLOCK = 128
D_CONV = D_MODEL // 2
CONV_WIDTH = 31
N_DIFF_HEADS = 4
DIFF_HEAD_DIM = 64
VALUE_HEAD_DIM = 2 * DIFF_HEAD_DIM
D_ATTN = N_DIFF_HEADS * VALUE_HEAD_DIM
D_IN = 2 * D_CONV + 3 * D_ATTN
REL_BUCKETS = 32
REL_MAX_DIST = 128
N_EXPERTS = 32
TOP_K = 4
D_FF = D_MODEL
SWIGLU_LIMIT = 7.0
SWIGLU_ALPHA = 1.702
MOE_BLOCK = 128
EPS = 1e-5

kernel_name = "hybrid_conv_diffattn_moe_block"


def rms_norm(x, g):
    xf = x.astype(jnp.float32)
    y = xf * lax.rsqrt(jnp.mean(xf * xf, axis=-1, keepdims=True) + EPS)
    return (y * g.astype(jnp.float32)).astype(x.dtype)


def layer_norm(x, g, b):
    xf = x.astype(jnp.float32)
    mu = jnp.mean(xf, axis=-1, keepdims=True)
    xc = xf - mu
    y = xc * lax.rsqrt(jnp.mean(xc * xc, axis=-1, keepdims=True) + EPS)
    return (y * g.astype(jnp.float32) + b.astype(jnp.float32)).astype(x.dtype)


def t5_bucket(rel):
    nb = REL_BUCKETS // 2
    max_exact = nb // 2
    ret = jnp.where(rel > 0, nb, 0)
    n = jnp.abs(rel)
    nf = jnp.maximum(n, 1).astype(jnp.float32)
    large = max_exact + (jnp.log(nf / max_exact) / math.log(REL_MAX_DIST / max_exact)
                         * (nb - max_exact)).astype(jnp.int32)
    large = jnp.minimum(large, nb - 1)
    return ret + jnp.where(n < max_exact, n, large)


def conv_mixer(a, g, conv_w, conv_b, ln_g, ln_b):
    u = a * jax.nn.sigmoid(g)
    kern = conv_w[:, None, :].astype(u.dtype)
    y = lax.conv_general_dilated(u, kern, window_strides=(1,),
                                 padding=[(CONV_WIDTH - 1, 0)],
                                 dimension_numbers=('NWC', 'WIO', 'NWC'),
                                 feature_group_count=D_CONV)
    y = layer_norm(y + conv_b, ln_g, ln_b)
    return jax.nn.silu(y)


def diff_attention(q, k, v, q_g, k_g, lam_qk, subln_g, rel_bias, lambda_init):
    B, S = q.shape[0], q.shape[1]
    q = rms_norm(q, q_g).transpose(0, 2, 3, 1, 4)
    k = rms_norm(k, k_g).transpose(0, 2, 3, 1, 4)
    v = v.transpose(0, 2, 1, 3)
    lf = lam_qk.astype(jnp.float32)
    lam = jnp.exp(jnp.sum(lf[0] * lf[1])) - jnp.exp(jnp.sum(lf[2] * lf[3])) + lambda_init
    scale = DIFF_HEAD_DIM ** -0.5
    table = rel_bias.astype(jnp.float32)
    outs = []
    for qb in range(S // Q_BLOCK):
        q0 = qb * Q_BLOCK
        end = q0 + Q_BLOCK
        qi = q[:, :, :, q0:end]
        kj = k[:, :, :, :end]
        vj = v[:, :, :end]
        s = jnp.einsum('bhmqd,bhmkd->bhmqk', qi, kj).astype(jnp.float32) * scale
        qpos = jnp.arange(q0, end, dtype=jnp.int32)[:, None]
        kpos = jnp.arange(end, dtype=jnp.int32)[None, :]
        bias = table[t5_bucket(kpos - qpos)].transpose(2, 0, 1)
        s = s + bias[None, :, None]
        allowed = (kpos // CHUNK) <= (qpos // CHUNK)
        s = jnp.where(allowed, s, -jnp.inf)
        p = jax.nn.softmax(s, axis=-1)
        pd = p[:, :, 0] - lam * p[:, :, 1]
        outs.append(jnp.einsum('bhqk,bhkv->bhqv', pd.astype(v.dtype), vj))
    o = jnp.concatenate(outs, axis=2)
    o = rms_norm(o, subln_g) * (1.0 - lambda_init)
    return o.transpose(0, 2, 1, 3).reshape(B, S, D_ATTN)


def moe_ffn(h, router_w, router_b, w_gate_up, b_gate_up, w_down, b_down):
    B, S, D = h.shape
    N = B * S
    xt = h.reshape(N, D)
    logits = (xt @ router_w).astype(jnp.float32) + router_b.astype(jnp.float32)
    top_vals, top_idx = lax.top_k(logits, TOP_K)
    gates = jax.nn.softmax(top_vals, axis=-1)
    NK = N * TOP_K
    e_flat = top_idx.reshape(-1)
    t_flat = jnp.arange(NK, dtype=jnp.int32) // TOP_K
    g_flat = gates.reshape(-1)
    order = jnp.argsort(e_flat)
    e_sorted = e_flat[order]
    counts = jnp.bincount(e_flat, length=N_EXPERTS)
    padded = (counts + MOE_BLOCK - 1) // MOE_BLOCK * MOE_BLOCK
    pad_end = jnp.cumsum(padded)
    pad_start = pad_end - padded
    start = jnp.cumsum(counts) - counts
    rank = jnp.arange(NK, dtype=jnp.int32) - start[e_sorted]
    dest = pad_start[e_sorted] + rank
    n_blocks = -(-NK // MOE_BLOCK) + N_EXPERTS
    L = n_blocks * MOE_BLOCK
    buf_tok = jnp.full((L,), N, dtype=jnp.int32).at[dest].set(t_flat[order])
    buf_gate = jnp.zeros((L,), jnp.float32).at[dest].set(g_flat[order])
    block_start = jnp.arange(n_blocks, dtype=jnp.int32) * MOE_BLOCK
    block_expert = jnp.minimum(jnp.searchsorted(pad_end, block_start, side='right'), N_EXPERTS - 1)
    x_pad = jnp.concatenate([xt, jnp.zeros((1, D), xt.dtype)], axis=0)
    xb = x_pad[buf_tok].reshape(n_blocks, MOE_BLOCK, D)

    def expert_block(args):
        xblk, e = args
        gu = xblk @ w_gate_up[e] + b_gate_up[e]
        gate = jnp.minimum(gu[:, 0::2], SWIGLU_LIMIT)
        lin = jnp.clip(gu[:, 1::2], -SWIGLU_LIMIT, SWIGLU_LIMIT)
        act = gate * jax.nn.sigmoid(SWIGLU_ALPHA * gate) * (lin + 1.0)
        return act @ w_down[e] + b_down[e]

    yb = lax.map(expert_block, (xb, block_expert)).reshape(L, D)
    y = jnp.zeros((N + 1, D), jnp.float32).at[buf_tok].add(yb.astype(jnp.float32) * buf_gate[:, None])
    return y[:N].astype(h.dtype).reshape(B, S, D)


def setup_inputs(seed: int = 0) -> dict:
    key = jax.random.key(seed)
    ks = jax.random.split(key, 21)
    f32 = jnp.float32

    def nrm(k, shape, scale):
        return jax.random.normal(k, shape, f32) * scale

    return {
        "x": nrm(ks[0], (BATCH, SEQ, D_MODEL), 1.0),
        "norm_mix_g": 1.0 + nrm(ks[1], (DEPTH, D_MODEL), 0.02),
        "w_in": nrm(ks[2], (DEPTH, D_MODEL, D_IN), D_MODEL ** -0.5),
        "conv_w": nrm(ks[3], (DEPTH, CONV_WIDTH, D_CONV), CONV_WIDTH ** -0.5),
        "conv_b": nrm(ks[4], (DEPTH, D_CONV), 0.01),
        "conv_ln_g": 1.0 + nrm(ks[5], (DEPTH, D_CONV), 0.02),
        "conv_ln_b": nrm(ks[6], (DEPTH, D_CONV), 0.01),
        "q_norm_g": 1.0 + nrm(ks[7], (DEPTH, 2, DIFF_HEAD_DIM), 0.02),
        "k_norm_g": 1.0 + nrm(ks[8], (DEPTH, 2, DIFF_HEAD_DIM), 0.02),
        "lambda_qk": nrm(ks[9], (DEPTH, 4, DIFF_HEAD_DIM), 0.1),
        "subln_g": 1.0 + nrm(ks[10], (DEPTH, VALUE_HEAD_DIM), 0.02),
        "rel_bias": nrm(ks[11], (REL_BUCKETS, N_DIFF_HEADS), 0.5),
        "w_out": nrm(ks[12], (DEPTH, D_CONV + D_ATTN, D_MODEL), (D_CONV + D_ATTN) ** -0.5),
        "norm_ffn_g": 1.0 + nrm(ks[13], (DEPTH, D_MODEL), 0.02),
        "router_w": nrm(ks[14], (DEPTH, D_MODEL, N_EXPERTS), D_MODEL ** -0.5),
        "router_b": nrm(ks[15], (DEPTH, N_EXPERTS), 0.01),
        "w_gate_up": nrm(ks[16], (DEPTH, N_EXPERTS, D_MODEL, 2 * D_FF), D_MODEL ** -0.5),
        "b_gate_up": nrm(ks[17], (DEPTH, N_EXPERTS, 2 * D_FF), 0.01),
        "w_down": nrm(ks[18], (DEPTH, N_EXPERTS, D_FF, D_MODEL), D_FF ** -0.5),
        "b_down": nrm(ks[19], (DEPTH, N_EXPERTS, D_MODEL), 0.01),
    }


def reference(x, norm_mix_g, w_in, conv_w, conv_b, conv_ln_g, conv_ln_b, q_norm_g, k_norm_g,
              lambda_qk, subln_g, rel_bias, w_out, norm_ffn_g, router_w, router_b,
              w_gate_up, b_gate_up, w_down, b_down):
    B, S, _ = x.shape
    h = x
    for layer in range(DEPTH):
        lambda_init = 0.8 - 0.6 * math.exp(-0.3 * layer)
        u = rms_norm(h, norm_mix_g[layer])
        proj = u @ w_in[layer]
        a, g, q, k, v = jnp.split(
            proj, [D_CONV, 2 * D_CONV, 2 * D_CONV + D_ATTN, 2 * D_CONV + 2 * D_ATTN], axis=-1)
        conv_out = conv_mixer(a, g, conv_w[layer], conv_b[layer], conv_ln_g[layer], conv_ln_b[layer])
        q = q.reshape(B, S, N_DIFF_HEADS, 2, DIFF_HEAD_DIM)
        k = k.reshape(B, S, N_DIFF_HEADS, 2, DIFF_HEAD_DIM)
        v = v.reshape(B, S, N_DIFF_HEADS, VALUE_HEAD_DIM)
        attn_out = diff_attention(q, k, v, q_norm_g[layer], k_norm_g[layer], lambda_qk[layer],
                                  subln_g[layer], rel_bias, lambda_init)
        mixed = jnp.concatenate([conv_out, attn_out], axis=-1)
        h = h + mixed @ w_out[layer]
        hn = rms_norm(h, norm_ffn_g[layer])
        h = h + moe_ffn(hn, router_w[layer], router_b[layer], w_gate_up[layer], b_gate_up[layer],
                        w_down[layer], b_down[layer])
    return h
```

```cpp
#include <hip/hip_runtime.h>
#include <cstdio>
#include <cstdint>

#ifndef MK_ONE_LAUNCH
#define MK_ONE_LAUNCH 0
#endif

#define GAS __attribute__((address_space(1)))
#define LAS __attribute__((address_space(3)))
typedef unsigned short bf16;
typedef short bf16x8 __attribute__((ext_vector_type(8)));
typedef float f32x4 __attribute__((ext_vector_type(4)));
typedef float f32x2 __attribute__((ext_vector_type(2)));
typedef float f32x16 __attribute__((ext_vector_type(16)));
typedef unsigned u32x4 __attribute__((ext_vector_type(4)));
typedef unsigned u32x2 __attribute__((ext_vector_type(2)));

constexpr int NB = 8, SEQ = 2048, DM = 1024, NTOK = NB * SEQ;
constexpr int DCONV = 512, CWID = 31, NH = 4, DH = 64, DV = 128, DATT = 512, DIN = 2560;
constexpr int NE = 32, TOPK = 4, DFF = 1024;
constexpr float EPS = 1e-5f;
constexpr float LOG2E = 1.4426950408889634f;
constexpr int LIST_CAP = NTOK;
constexpr int MAX_RB = NTOK * TOPK / 256 + NE;

constexpr size_t MiB = 1u << 20;
constexpr size_t WS_CTL = 0, CTL_ZERO_BYTES = 1 * MiB;
constexpr size_t WS_WIN = 2 * MiB;
constexpr size_t WS_WOUT = 8 * MiB;
constexpr size_t WS_WGU = 16 * MiB;
constexpr size_t WS_WD = 144 * MiB;
constexpr size_t WS_XN = 208 * MiB;
constexpr size_t WS_PROJ = 240 * MiB;
constexpr size_t WS_VT = 320 * MiB;
constexpr size_t WS_MIX = 336 * MiB;
constexpr size_t WS_LIST = 368 * MiB;
constexpr size_t WS_GATES = 370 * MiB;
constexpr size_t WS_ACT = 372 * MiB;
constexpr size_t WS_YB = 516 * MiB;
constexpr size_t WS_END = 644 * MiB;
constexpr int CW_BAR = 4096;
constexpr int CW_CNT = 8192;

constexpr int RING_BYTES = 131072;
constexpr int LDSX_OFF = RING_BYTES;
constexpr int MISC_OFF = RING_BYTES + 8192;
constexpr int LDS_BYTES = 147456;
constexpr int NWAVES = 8;

#define LDS_WAIT() asm volatile("s_waitcnt lgkmcnt(0)" ::: "memory")
#define VM_WAIT() asm volatile("s_waitcnt vmcnt(0)" ::: "memory")
#define RLX_AGENT __ATOMIC_RELAXED, __HIP_MEMORY_SCOPE_AGENT

__device__ __forceinline__ unsigned f2bf(float f) { unsigned u = __builtin_bit_cast(unsigned, f); return (u + 0x7fffu + ((u >> 16) & 1u)) >> 16; }
__device__ __forceinline__ unsigned pk2(float lo, float hi) { unsigned r; asm volatile("v_cvt_pk_bf16_f32 %0, %1, %2" : "=v"(r) : "v"(lo), "v"(hi)); return r; }
__device__ __forceinline__ float bf2f(unsigned short b) { return __builtin_bit_cast(float, (unsigned)b << 16); }
__device__ __forceinline__ float bflo(unsigned w) { return __builtin_bit_cast(float, w << 16); }
__device__ __forceinline__ float bfhi(unsigned w) { return __builtin_bit_cast(float, w & 0xffff0000u); }
__device__ __forceinline__ float wave_sum(float v) {
#pragma unroll
    for (int o = 1; o < 64; o <<= 1) v += __shfl_xor(v, o);
    return v;
}

namespace pg8 {
constexpr int BM = 256, BK = 64, HALF = 128, HTB = HALF * BK * 2, STAGE_BYTES = 8 * HTB, NXCD = 8, WGM = 8;
__host__ __device__ __forceinline__ int lds_byte(int r, int c) { const int st = (r >> 4) * 2 + (c >> 5), rr = r & 15, cc = c & 31, ob = rr * 64 + cc * 2; return st * 1024 + (ob ^ (((ob >> 9) & 1) << 5)); }
__host__ __device__ __forceinline__ void stage_rc(int b, int& R, int& C) { const int st = b / 1024, sb = b % 1024, swz = sb ^ (((sb >> 9) & 1) << 5); R = (st >> 1) * 16 + swz / 64; C = (st & 1) * 32 + (swz % 64) / 2; }
__host__ __device__ __forceinline__ int perm32(int rho) { const int n = rho >> 4, i = rho & 15; return 8 * (i >> 2) + 4 * n + (i & 3); }

struct Unit { int pm, pn, e, rb, nvalid; };

struct DenseSched {
    const char* A; const char* Bt; int K; int nM, nN, nwg, G, c;
    __device__ __forceinline__ void init(const void* A_, const void* Bt_, int M, int N, int K_, int G_, int c_) { A = (const char*)A_; Bt = (const char*)Bt_; K = K_; nM = M / BM; nN = N / BM; nwg = nM * nN; G = G_; c = c_; }
    __device__ __forceinline__ bool next(int i, Unit& u) const {
        const long L = (long)i * G + c; if (L >= nwg) return false;
        int wgid = (int)L; { const int q = nwg / NXCD, r = nwg % NXCD, xcd = wgid % NXCD, off = wgid / NXCD; wgid = (xcd < r ? xcd * (q + 1) : r * (q + 1) + (xcd - r) * q) + off; }
        const int nig = WGM * nN, gid = wgid / nig, fm = gid * WGM, gsz = (nM - fm) < WGM ? (nM - fm) : WGM;
        u.pm = fm + ((wgid % nig) % gsz); u.pn = (wgid % nig) / gsz; u.e = 0; u.rb = 0; u.nvalid = 256; return true;
    }
    __device__ __forceinline__ const char* a_base() const { return A; }
    __device__ __forceinline__ void a_offsets(const Unit& u, const int (&Rr)[2], const int (&Cc)[2], unsigned (&o)[2][2]) const {
#pragma unroll
        for (int h = 0; h < 2; ++h)
#pragma unroll
            for (int i = 0; i < 2; ++i) o[h][i] = (unsigned)((u.pm * BM + h * HALF + Rr[i]) * K + Cc[i]) * 2u;
    }
    __device__ __forceinline__ const char* b_ptr(const Unit& u) const { return Bt + (size_t)u.pn * BM * K * 2; }
};

struct MoeSched {
    const char* A; const char* Bt; const int* list; int K; int ncb; int total; int G, c; int pre_lane, cnt_lane; bool gather; size_t estride;
    __device__ __forceinline__ bool next(int i, Unit& u) const {
        const int L = i * G + c; if (L >= total) return false;
        const int R = L / ncb, cb = L - R * ncb;
        const unsigned long long m = __ballot(R >= pre_lane);
        const int e = __popcll(m);
        const int prev = e ? __builtin_amdgcn_readlane(pre_lane, e - 1) : 0;
        const int cnt = __builtin_amdgcn_readlane(cnt_lane, e);
        u.pm = R; u.pn = cb; u.e = e; u.rb = R - prev; const int left = cnt - u.rb * 256; u.nvalid = left < 256 ? left : 256; return true;
    }
    __device__ __forceinline__ const char* a_base() const { return A; }
    __device__ __forceinline__ void a_offsets(const Unit& u, const int (&Rr)[2], const int (&Cc)[2], unsigned (&o)[2][2]) const {
#pragma unroll
        for (int h = 0; h < 2; ++h)
#pragma unroll
            for (int i = 0; i < 2; ++i) {
                const int r = h * HALF + Rr[i]; int row;
                if (gather) { row = 0; if (r < u.nvalid) row = list[u.e * LIST_CAP + u.rb * 256 + r] >> 2; }
                else row = u.pm * BM + r;
                o[h][i] = (unsigned)(row * K + Cc[i]) * 2u;
            }
    }
    __device__ __forceinline__ const char* b_ptr(const Unit& u) const { return Bt + (size_t)u.e * estride + (size_t)u.pn * BM * K * 2; }
};

struct EpiBf16 {
    static constexpr bool PERM = true;
    bf16* O; int ldc;
    __device__ __forceinline__ void operator()(const f32x4 (&acc)[2][2][4][2], const Unit& u, int wr, int wc, int fr, int fq) const {
        const int row0 = u.pm * BM + wr * 64 + fr; const int col0 = u.pn * BM + wc * 32 + 8 * fq;
#pragma unroll
        for (int ai = 0; ai < 2; ++ai)
#pragma unroll
            for (int m = 0; m < 4; ++m) { bf16* rowp = O + (size_t)(row0 + ai * HALF + m * 16) * ldc + col0;
#pragma unroll
                for (int bj = 0; bj < 2; ++bj) { const f32x4 v0 = acc[ai][bj][m][0], v1 = acc[ai][bj][m][1];
                    u32x4 w; w.x = pk2(v0[0], v0[1]); w.y = pk2(v0[2], v0[3]); w.z = pk2(v1[0], v1[1]); w.w = pk2(v1[2], v1[3]);
                    *(u32x4*)(rowp + bj * HALF) = w; } }
    }
};
struct EpiResF32 {
    static constexpr bool PERM = false;
    const float* base; float* out; int ldc;
    __device__ __forceinline__ void operator()(const f32x4 (&acc)[2][2][4][2], const Unit& u, int wr, int wc, int fr, int fq) const {
        const int col0 = u.pn * BM + wc * 32 + 4 * fq;
#pragma unroll
        for (int ai = 0; ai < 2; ++ai)
#pragma unroll
            for (int m = 0; m < 4; ++m) { const size_t off = (size_t)(u.pm * BM + ai * HALF + wr * 64 + m * 16 + fr) * ldc + col0;
#pragma unroll
                for (int bj = 0; bj < 2; ++bj)
#pragma unroll
                    for (int n = 0; n < 2; ++n) { const f32x4 bs = *(const f32x4*)(base + off + bj * HALF + n * 16); *(f32x4*)(out + off + bj * HALF + n * 16) = bs + acc[ai][bj][m][n]; } }
    }
};
struct EpiSwiglu {
    static constexpr bool PERM = true;
    bf16* act; const float* bgu;
    __device__ __forceinline__ void operator()(const f32x4 (&acc)[2][2][4][2], const Unit& u, int wr, int wc, int fr, int fq) const {
        const int row0 = u.pm * BM + wr * 64 + fr; const int acol0 = u.pn * 128 + wc * 32 + 8 * fq;
        const float* bp = bgu + (size_t)u.e * 2048 + 2 * acol0;
        f32x4 bb[4];
#pragma unroll
        for (int i = 0; i < 4; ++i) bb[i] = *(const f32x4*)(bp + 4 * i);
        float bg[8], bl[8];
#pragma unroll
        for (int i = 0; i < 4; ++i) { bg[2 * i] = bb[i][0]; bl[2 * i] = bb[i][1]; bg[2 * i + 1] = bb[i][2]; bl[2 * i + 1] = bb[i][3]; }
#pragma unroll
        for (int ai = 0; ai < 2; ++ai)
#pragma unroll
            for (int m = 0; m < 4; ++m) {
                float o[8];
#pragma unroll
                for (int n = 0; n < 2; ++n)
#pragma unroll
                    for (int i = 0; i < 4; ++i) {
                        float g = acc[ai][0][m][n][i] + bg[4 * n + i], l = acc[ai][1][m][n][i] + bl[4 * n + i];
                        g = fminf(g, 7.0f); l = fminf(fmaxf(l, -7.0f), 7.0f);
                        const float sg = __builtin_amdgcn_rcpf(1.0f + __builtin_amdgcn_exp2f(-1.702f * LOG2E * g));
                        o[4 * n + i] = g * sg * (l + 1.0f);
                    }
                u32x4 w; w.x = pk2(o[0], o[1]); w.y = pk2(o[2], o[3]); w.z = pk2(o[4], o[5]); w.w = pk2(o[6], o[7]);
                *(u32x4*)(act + (size_t)(row0 + ai * HALF + m * 16) * DFF + acol0) = w;
            }
    }
};
struct EpiDown {
    static constexpr bool PERM = true;
    bf16* yb; const float* bd; const int* list; const float* gates;
    __device__ __forceinline__ void operator()(const f32x4 (&acc)[2][2][4][2], const Unit& u, int wr, int wc, int fr, int fq) const {
        const int col0 = u.pn * BM + wc * 32 + 8 * fq;
        f32x4 bv[2][2];
#pragma unroll
        for (int bj = 0; bj < 2; ++bj)
#pragma unroll
            for (int n = 0; n < 2; ++n) bv[bj][n] = *(const f32x4*)(bd + (size_t)u.e * DM + col0 + bj * HALF + 4 * n);
#pragma unroll
        for (int ai = 0; ai < 2; ++ai)
#pragma unroll
            for (int m = 0; m < 4; ++m) { const int r = ai * HALF + wr * 64 + m * 16 + fr;
                if (r < u.nvalid) {
                    const int entry = list[u.e * LIST_CAP + u.rb * 256 + r]; const float gw = gates[entry];
                    bf16* rowp = yb + (size_t)entry * DM + col0;
#pragma unroll
                    for (int bj = 0; bj < 2; ++bj) { const f32x4 v0 = (acc[ai][bj][m][0] + bv[bj][0]) * gw, v1 = (acc[ai][bj][m][1] + bv[bj][1]) * gw;
                        u32x4 w; w.x = pk2(v0[0], v0[1]); w.y = pk2(v0[2], v0[3]); w.z = pk2(v1[0], v1[1]); w.w = pk2(v1[2], v1[3]);
                        *(u32x4*)(rowp + bj * HALF) = w; } } }
    }
};

template <class Epi, class Sched, bool ALIGN_EPI, bool SP2>
__device__ __forceinline__ void gemm_phase(LAS unsigned char* lds, const int K, const Sched& S, const Epi& E) {
    const int tid = threadIdx.x, wid = __builtin_amdgcn_readfirstlane(tid >> 6), lane = tid & 63, wr = wid >> 2, wc = wid & 3, fr = lane & 15, fq = lane >> 4;
    const int nt = K / BK;
    int Rr[2], Cc[2]; unsigned voffB[2];
#pragma unroll
    for (int i = 0; i < 2; ++i) { int R, C; stage_rc(tid * 16 + i * 8192, R, C); const int Rb = Epi::PERM ? ((R & ~31) + perm32(R & 31)) : R;
        Rr[i] = R; Cc[i] = C; voffB[i] = (unsigned)(Rb * K + C) * 2u; }
    const size_t kstep = (size_t)(BK * 2);
    const size_t hstep = (size_t)HALF * K * 2;
    const unsigned ldsw = (unsigned)wid * 1024u;
    const int aoff = lds_byte(wr * 64 + fr, fq * 8), boff = lds_byte(wc * 32 + fr, fq * 8);
#define PG8_SA(b, h) (((b) * 2 + (h)) * HTB)
#define PG8_SB(b, h) ((4 + (b) * 2 + (h)) * HTB)
#define PG8_STAGE(bufoff, gbase, voff) do { _Pragma("unroll") for (int _i = 0; _i < 2; ++_i) \
        __builtin_amdgcn_global_load_lds((const unsigned*)((const char*)(gbase) + (voff)[_i]), (LAS unsigned*)(lds + (bufoff) + ldsw + _i * 8192), 16, 0, 0); } while (0)
#define PG8_LDA(dst, b, h) do { _Pragma("unroll") for (int m = 0; m < 4; ++m) _Pragma("unroll") for (int k = 0; k < 2; ++k) dst[m][k] = *(const LAS bf16x8*)(lds + PG8_SA(b, h) + aoff + m * 2048 + k * 1024); } while (0)
#define PG8_LDB(dst, b, h) do { _Pragma("unroll") for (int n = 0; n < 2; ++n) _Pragma("unroll") for (int k = 0; k < 2; ++k) dst[n][k] = *(const LAS bf16x8*)(lds + PG8_SB(b, h) + boff + n * 2048 + k * 1024); } while (0)
#define PG8_MMA(ai, bj, At, Bt) do { __builtin_amdgcn_s_setprio(1); _Pragma("unroll") for (int m = 0; m < 4; ++m) _Pragma("unroll") for (int n = 0; n < 2; ++n) _Pragma("unroll") for (int k = 0; k < 2; ++k) \
        acc[ai][bj][m][n] = __builtin_amdgcn_mfma_f32_16x16x32_bf16(Bt[n][k], At[m][k], acc[ai][bj][m][n], 0, 0, 0); __builtin_amdgcn_s_setprio(0); } while (0)
#define PG8_WAIT_V(n) asm volatile("s_waitcnt vmcnt(" #n ")" ::: "memory")
#define PG8_WAIT_L(n) asm volatile("s_waitcnt lgkmcnt(" #n ")" ::: "memory")
#define PG8_BAR __builtin_amdgcn_s_barrier()
#define PG8_SCHED __builtin_amdgcn_sched_barrier(0)
    Unit cur, nxt; int ui = 0;
    if (!S.next(0, cur)) return;
    f32x4 acc[2][2][4][2];
#pragma unroll
    for (int a = 0; a < 2; ++a)
#pragma unroll
        for (int b = 0; b < 2; ++b)
#pragma unroll
            for (int m = 0; m < 4; ++m)
#pragma unroll
                for (int n = 0; n < 2; ++n) acc[a][b][m][n] = (f32x4){0.f, 0.f, 0.f, 0.f};
    bf16x8 At[4][2], B0[2][2], B1[2][2];
    const char* gA = S.a_base();
    unsigned cvA[2][2], nvA[2][2];
    S.a_offsets(cur, Rr, Cc, cvA);
    const char* cB = S.b_ptr(cur);
    if constexpr (SP2) {
        PG8_STAGE(PG8_SB(0, 0), cB, voffB); PG8_STAGE(PG8_SB(0, 1), cB + hstep, voffB); PG8_STAGE(PG8_SA(0, 0), gA, cvA[0]); PG8_STAGE(PG8_SA(0, 1), gA, cvA[1]);
        if (wr == 1) PG8_BAR;
        PG8_WAIT_V(2); PG8_BAR;
        PG8_STAGE(PG8_SB(1, 0), cB + kstep, voffB); PG8_STAGE(PG8_SA(1, 0), gA + kstep, cvA[0]); PG8_STAGE(PG8_SB(1, 1), cB + hstep + kstep, voffB);
        PG8_WAIT_V(6); PG8_BAR;
    } else {
        PG8_STAGE(PG8_SB(0, 0), cB, voffB); PG8_STAGE(PG8_SA(0, 0), gA, cvA[0]); PG8_STAGE(PG8_SB(0, 1), cB + hstep, voffB); PG8_STAGE(PG8_SA(0, 1), gA, cvA[1]);
        if (wr == 1) PG8_BAR;
        PG8_WAIT_V(4); PG8_BAR;
        PG8_STAGE(PG8_SB(1, 0), cB + kstep, voffB); PG8_STAGE(PG8_SA(1, 0), gA + kstep, cvA[0]); PG8_STAGE(PG8_SB(1, 1), cB + hstep + kstep, voffB);
        PG8_WAIT_V(6); PG8_BAR;
    }
    for (;;) {
        const bool has_next = S.next(ui + 1, nxt);
        const char* nB = cB;
        if (has_next) { S.a_offsets(nxt, Rr, Cc, nvA); nB = S.b_ptr(nxt); }
        else {
#pragma unroll
            for (int h = 0; h < 2; ++h)
#pragma unroll
                for (int i = 0; i < 2; ++i) nvA[h][i] = cvA[h][i];
        }
        for (int t = 0; t < nt; t += 2) {
            const bool last = (t == nt - 2);
            const char* a1 = gA + (size_t)(t + 1) * kstep;
            const char* a2 = last ? gA : gA + (size_t)(t + 2) * kstep; const char* b2 = last ? nB : cB + (size_t)(t + 2) * kstep;
            const char* a3 = a2 + kstep; const char* b3 = b2 + kstep;
            unsigned o2[2][2];
#pragma unroll
            for (int h = 0; h < 2; ++h)
#pragma unroll
                for (int i = 0; i < 2; ++i) o2[h][i] = last ? nvA[h][i] : cvA[h][i];
            if constexpr (SP2) {
            PG8_LDB(B0, 0, 0); PG8_LDB(B1, 0, 1); PG8_SCHED; PG8_LDA(At, 0, 0); PG8_STAGE(PG8_SA(1, 1), a1, cvA[1]);
            PG8_WAIT_V(8); PG8_WAIT_L(0); PG8_BAR; PG8_MMA(0, 0, At, B0); PG8_MMA(0, 1, At, B1); PG8_BAR; PG8_SCHED;
            PG8_LDA(At, 0, 1); PG8_STAGE(PG8_SB(0, 0), b2, voffB); PG8_STAGE(PG8_SB(0, 1), b2 + hstep, voffB); PG8_STAGE(PG8_SA(0, 0), a2, o2[0]);
            PG8_WAIT_V(8); PG8_WAIT_L(0); PG8_BAR; PG8_MMA(1, 0, At, B0); PG8_MMA(1, 1, At, B1); PG8_BAR; PG8_SCHED;
            PG8_LDB(B0, 1, 0); PG8_LDB(B1, 1, 1); PG8_SCHED; PG8_LDA(At, 1, 0); PG8_STAGE(PG8_SA(0, 1), a2, o2[1]);
            PG8_WAIT_V(8); PG8_WAIT_L(0); PG8_BAR; PG8_MMA(0, 0, At, B0); PG8_MMA(0, 1, At, B1); PG8_BAR; PG8_SCHED;
            PG8_LDA(At, 1, 1); PG8_STAGE(PG8_SB(1, 0), b3, voffB); PG8_STAGE(PG8_SB(1, 1), b3 + hstep, voffB); PG8_STAGE(PG8_SA(1, 0), a3, o2[0]);
            PG8_WAIT_V(8); PG8_WAIT_L(0); PG8_BAR; PG8_MMA(1, 0, At, B0); PG8_MMA(1, 1, At, B1); PG8_BAR; PG8_SCHED;
            } else {
            PG8_LDB(B0, 0, 0); PG8_SCHED; PG8_LDA(At, 0, 0); PG8_STAGE(PG8_SA(1, 1), a1, cvA[1]);
            PG8_WAIT_L(8); PG8_BAR; PG8_WAIT_L(0); PG8_MMA(0, 0, At, B0); PG8_BAR; PG8_SCHED;
            PG8_LDB(B1, 0, 1); PG8_STAGE(PG8_SB(0, 0), b2, voffB);
            PG8_BAR; PG8_WAIT_L(0); PG8_MMA(0, 1, At, B1); PG8_BAR;
            PG8_LDA(At, 0, 1); PG8_STAGE(PG8_SA(0, 0), a2, o2[0]);
            PG8_BAR; PG8_WAIT_L(0); PG8_MMA(1, 0, At, B0); PG8_BAR; PG8_SCHED;
            PG8_STAGE(PG8_SB(0, 1), b2 + hstep, voffB);
            PG8_WAIT_V(6); PG8_BAR; PG8_MMA(1, 1, At, B1); PG8_BAR;
            PG8_LDB(B0, 1, 0); PG8_SCHED; PG8_LDA(At, 1, 0); PG8_STAGE(PG8_SA(0, 1), a2, o2[1]);
            PG8_WAIT_L(8); PG8_BAR; PG8_WAIT_L(0); PG8_MMA(0, 0, At, B0); PG8_BAR; PG8_SCHED;
            PG8_LDB(B1, 1, 1); PG8_STAGE(PG8_SB(1, 0), b3, voffB);
            PG8_BAR; PG8_WAIT_L(0); PG8_MMA(0, 1, At, B1); PG8_BAR;
            PG8_LDA(At, 1, 1); PG8_STAGE(PG8_SA(1, 0), a3, o2[0]);
            PG8_BAR; PG8_WAIT_L(0); PG8_MMA(1, 0, At, B0); PG8_BAR; PG8_SCHED;
            PG8_STAGE(PG8_SB(1, 1), b3 + hstep, voffB);
            PG8_WAIT_V(6); PG8_BAR; PG8_MMA(1, 1, At, B1); PG8_BAR;
            }
        }
        if constexpr (ALIGN_EPI) { if (wr == 0) PG8_BAR; }
        E(acc, cur, wr, wc, fr, fq);
        if (!has_next) break;
#pragma unroll
        for (int a = 0; a < 2; ++a)
#pragma unroll
            for (int b = 0; b < 2; ++b)
#pragma unroll
                for (int m = 0; m < 4; ++m)
#pragma unroll
                    for (int n = 0; n < 2; ++n) acc[a][b][m][n] = (f32x4){0.f, 0.f, 0.f, 0.f};
        cur = nxt; cB = nB; ++ui;
#pragma unroll
        for (int h = 0; h < 2; ++h)
#pragma unroll
            for (int i = 0; i < 2; ++i) cvA[h][i] = nvA[h][i];
        if constexpr (ALIGN_EPI) { if (wr == 1) PG8_BAR; }
    }
    PG8_WAIT_V(0);
    if constexpr (!ALIGN_EPI) { if (wr == 0) PG8_BAR; }
    PG8_BAR;
#undef PG8_SA
#undef PG8_SB
#undef PG8_STAGE
#undef PG8_LDA
#undef PG8_LDB
#undef PG8_MMA
#undef PG8_WAIT_V
#undef PG8_WAIT_L
#undef PG8_BAR
#undef PG8_SCHED
}
}

#define XB_TMO      128
#define XB_XCNT(j)  (256  + 64 * (j))
#define XB_XSUB(j)  (1280 + 64 * (j))
#define XB_XGEN(j)  (2304 + 64 * (j))
#define XB_TOP      3328
#define XB_TOPGEN   3392
#define XCD_BAR_WORDS 3456
#define XB_SPIN_CAP (1u << 18)
__device__ __forceinline__ unsigned xb_ld(unsigned* p)              { return __hip_atomic_load(p, __ATOMIC_RELAXED, __HIP_MEMORY_SCOPE_AGENT); }
__device__ __forceinline__ unsigned xb_add(unsigned* p, unsigned v) { return __hip_atomic_fetch_add(p, v, __ATOMIC_RELAXED, __HIP_MEMORY_SCOPE_AGENT); }
__device__ __forceinline__ unsigned xb_xcc_id() { return (unsigned)__builtin_amdgcn_s_getreg((3 << 11) | 20) & 0xFu; }
#define XB_SPIN(cond, bar) do { unsigned _sp = 0; while (cond) { __builtin_amdgcn_s_sleep(1); \
    if ((++_sp & 255u) == 0u) { if (xb_ld(&(bar)[XB_TMO])) break; if (_sp > XB_SPIN_CAP) { atomicAdd(&(bar)[XB_TMO], 1u); break; } } } } while (0)
struct XcdBarrier { unsigned* bar; unsigned x; volatile LAS unsigned* st; };
__device__ __forceinline__ XcdBarrier xcd_barrier_post(unsigned* bar, volatile LAS unsigned* st) {
    XcdBarrier b; b.bar = bar; b.x = xb_xcc_id(); b.st = st;
    if (threadIdx.x == 0) (void)xb_add(&bar[XB_XCNT(b.x)], 1u);
    return b;
}
__device__ __forceinline__ void xcd_barrier_complete(unsigned* bar, unsigned x, unsigned& nloc, unsigned& nx) {
    const unsigned G = gridDim.x * gridDim.y * gridDim.z;
    unsigned sum, cnt, mine, sp = 0u;
    for (;;) {
        sum = 0u; cnt = 0u; mine = 0u;
#pragma unroll
        for (unsigned j = 0; j < 16; ++j) { const unsigned c = xb_ld(&bar[XB_XCNT(j)]); sum += c; cnt += (c > 0u) ? 1u : 0u; mine = (j == x) ? c : mine; }
        if (sum == G) break;
        __builtin_amdgcn_s_sleep(1);
        if ((++sp & 255u) == 0u) { if (xb_ld(&bar[XB_TMO])) break; if (sp > XB_SPIN_CAP) { atomicAdd(&bar[XB_TMO], 1u); break; } }
    }
    nloc = mine > 0u ? mine : 1u; nx = cnt > 0u ? cnt : 1u;
}
__device__ __forceinline__ void xcd_barrier(const XcdBarrier& b) {
    asm volatile("s_waitcnt vmcnt(0)" ::: "memory");
    __syncthreads();
    if (threadIdx.x == 0) {
        unsigned* bar = b.bar;
        __builtin_amdgcn_s_waitcnt(0);
        unsigned nloc = b.st[0], nx = b.st[1];
        if (nloc == 0u) { xcd_barrier_complete(bar, b.x, nloc, nx); b.st[0] = nloc; b.st[1] = nx; }
        const unsigned old = xb_add(&bar[XB_XSUB(b.x)], 1u);
        const unsigned gen = old / nloc;
        if (old + 1u == (gen + 1u) * nloc) {
            __builtin_amdgcn_fence(__ATOMIC_RELEASE, "agent");
            asm volatile("s_waitcnt vmcnt(0)" ::: "memory");
            const unsigned og = xb_add(&bar[XB_TOP], 1u);
            const unsigned tg = og / nx;
            if (og + 1u == (tg + 1u) * nx) xb_add(&bar[XB_TOPGEN], 1u);
            else XB_SPIN(xb_ld(&bar[XB_TOPGEN]) == tg, bar);
            __builtin_amdgcn_fence(__ATOMIC_ACQUIRE, "agent");
            xb_add(&bar[XB_XGEN(b.x)], 1u);
            asm volatile("s_waitcnt vmcnt(0)" ::: "memory");
        } else {
            XB_SPIN(xb_ld(&bar[XB_XGEN(b.x)]) == gen, bar);
            __builtin_amdgcn_fence(__ATOMIC_ACQUIRE, "agent");
            asm volatile("s_waitcnt vmcnt(0)" ::: "memory");
        }
    }
    __syncthreads();
}

struct Args { const float* in[20]; float* out; unsigned char* ws; int ph_lo, ph_hi; };
enum { I_X = 0, I_G1, I_WIN, I_CONVW, I_CONVB, I_LNG, I_LNB, I_QG, I_KG, I_LAMQK, I_SUBG, I_RELB, I_WOUT, I_G2, I_RW, I_RB, I_WGU, I_BGU, I_WD, I_BD };

struct Frame {
    LAS unsigned char* lds;
    int tid, lane, wave, vcu, G;
    const float* const* in;
    float* out; unsigned char* ws;
};

template <int MODE>
__device__ __forceinline__ void transpose_item64(const float* W, int K, int N, bf16* WT, int row_off, LAS float* scr, int item, int lane) {
    const int nblk = N / 64, kb = item / nblk, nb = item - kb * nblk, k0 = 64 * kb, n0 = 64 * nb;
    f32x4 v[16];
#pragma unroll
    for (int it = 0; it < 16; ++it) { const int kr = 4 * it + (lane >> 4); v[it] = *(const GAS f32x4*)(W + (size_t)(k0 + kr) * N + n0 + 4 * (lane & 15)); }
#pragma unroll
    for (int it = 0; it < 16; ++it) { const int kr = 4 * it + (lane >> 4); const int col = (4 * (lane & 15) + 8 * (kr >> 3)) & 63; *(LAS f32x4*)(scr + kr * 64 + col) = v[it]; }
    LDS_WAIT(); asm volatile("" ::: "memory");
    const int kc = lane & 7;
#pragma unroll
    for (int jt = 0; jt < 8; ++jt) { const int n = 8 * jt + (lane >> 3); const int col = (n + 8 * kc) & 63; const LAS float* s = scr + (8 * kc) * 64 + col;
        u32x4 o; o.x = pk2(s[0], s[64]); o.y = pk2(s[128], s[192]); o.z = pk2(s[256], s[320]); o.w = pk2(s[384], s[448]);
        int row;
        if (MODE == 0) row = row_off + n0 + n;
        else { const int c = n0 + n, j = c >> 1; row = row_off + (j >> 7) * 256 + (j & 127) + 128 * (c & 1); }
        *(GAS u32x4*)(WT + (size_t)row * K + k0 + 8 * kc) = o; }
    LDS_WAIT(); asm volatile("" ::: "memory");
}
__device__ __forceinline__ void rms_row_to_bf16(int lane, const float* xrow, const float* g, bf16* orow) {
    const GAS f32x4* xr = (const GAS f32x4*)xrow + lane;
    f32x4 v[4]; float s = 0.f;
#pragma unroll
    for (int j = 0; j < 4; ++j) { v[j] = xr[64 * j]; s += (v[j].x * v[j].x + v[j].y * v[j].y) + (v[j].z * v[j].z + v[j].w * v[j].w); }
    const float rstd = 1.0f / sqrtf(wave_sum(s) * (1.f / DM) + EPS);
    GAS u32x2* o8 = (GAS u32x2*)orow + lane;
#pragma unroll
    for (int j = 0; j < 4; ++j) { const f32x4 gg = *((const GAS f32x4*)g + lane + 64 * j); u32x2 w; w.x = pk2(v[j].x * rstd * gg.x, v[j].y * rstd * gg.y); w.y = pk2(v[j].z * rstd * gg.z, v[j].w * rstd * gg.w); o8[64 * j] = w; }
}

__device__ __forceinline__ void p0_prologue(Frame& F) {
    LAS float* scr = (LAS float*)(F.lds + F.wave * 16384);
    const int gw = F.vcu * NWAVES + F.wave, NGW = F.G * NWAVES;
    constexpr int I_IN = (DM / 64) * (DIN / 64), I_OUT = (DM / 64) * (DM / 64), I_GU1 = (DM / 64) * (2 * DFF / 64), I_D1 = (DFF / 64) * (DM / 64);
    constexpr int NITEMS = I_IN + I_OUT + NE * I_GU1 + NE * I_D1;
    bf16* Win_t = (bf16*)(F.ws + WS_WIN); bf16* Wout_t = (bf16*)(F.ws + WS_WOUT); bf16* Wgu_t = (bf16*)(F.ws + WS_WGU); bf16* Wd_t = (bf16*)(F.ws + WS_WD);
    for (int it = gw; it < NITEMS; it += NGW) {
        int r = it;
        if (r < I_IN) { transpose_item64<0>(F.in[I_WIN], DM, DIN, Win_t, 0, scr, r, F.lane); continue; } r -= I_IN;
        if (r < I_OUT) { transpose_item64<0>(F.in[I_WOUT], DM, DM, Wout_t, 0, scr, r, F.lane); continue; } r -= I_OUT;
        if (r < NE * I_GU1) { const int e = r / I_GU1, q = r - e * I_GU1; transpose_item64<1>(F.in[I_WGU] + (size_t)e * DM * 2 * DFF, DM, 2 * DFF, Wgu_t + (size_t)e * 2 * DFF * DM, 0, scr, q, F.lane); continue; } r -= NE * I_GU1;
        { const int e = r / I_D1, q = r - e * I_D1; transpose_item64<0>(F.in[I_WD] + (size_t)e * DFF * DM, DFF, DM, Wd_t + (size_t)e * DM * DFF, 0, scr, q, F.lane); }
    }
    bf16* XN = (bf16*)(F.ws + WS_XN);
    for (int m = gw; m < NTOK; m += NGW) rms_row_to_bf16(F.lane, F.in[I_X] + (size_t)m * DM, F.in[I_G1], XN + (size_t)m * DM);
}

__device__ __forceinline__ void p2_prep(Frame& F) {
    bf16* proj = (bf16*)(F.ws + WS_PROJ); bf16* Vt = (bf16*)(F.ws + WS_VT);
    const int lane = F.lane;
    for (int tile = F.vcu; tile < NTOK / 64; tile += F.G) {
        const int tok0 = tile * 64;
        const bool isq = lane < 32; const int d0 = (16 * lane) & 63, map = (lane >> 2) & 1;
        const float* gp = (isq ? F.in[I_QG] : F.in[I_KG]) + map * 64 + d0;
        float gg[16];
#pragma unroll
        for (int i = 0; i < 4; ++i) { const f32x4 t = *(const GAS f32x4*)(gp + 4 * i); gg[4 * i] = t.x; gg[4 * i + 1] = t.y; gg[4 * i + 2] = t.z; gg[4 * i + 3] = t.w; }
        const float sc = isq ? 0.125f * LOG2E : 1.0f;
#pragma unroll 2
        for (int tt = 0; tt < 8; ++tt) {
            bf16* p = proj + (size_t)(tok0 + F.wave * 8 + tt) * DIN + 1024 + 16 * lane;
            const u32x4 a = *(const GAS u32x4*)p, b = *(const GAS u32x4*)(p + 8);
            float v[16];
#pragma unroll
            for (int i = 0; i < 4; ++i) { v[2 * i] = bflo(a[i]); v[2 * i + 1] = bfhi(a[i]); v[8 + 2 * i] = bflo(b[i]); v[9 + 2 * i] = bfhi(b[i]); }
            float ss = 0.f;
#pragma unroll
            for (int i = 0; i < 16; ++i) ss += v[i] * v[i];
            ss += __shfl_xor(ss, 1); ss += __shfl_xor(ss, 2);
            const float rstd = sc / sqrtf(ss * (1.0f / 64.0f) + EPS);
            u32x4 oa, ob;
#pragma unroll
            for (int i = 0; i < 4; ++i) { oa[i] = pk2(v[2 * i] * rstd * gg[2 * i], v[2 * i + 1] * rstd * gg[2 * i + 1]); ob[i] = pk2(v[8 + 2 * i] * rstd * gg[8 + 2 * i], v[9 + 2 * i] * rstd * gg[9 + 2 * i]); }
            *(GAS u32x4*)p = oa; *(GAS u32x4*)(p + 8) = ob;
        }
        {
            const int b = tok0 / SEQ, s0 = tok0 % SEQ;
            const bf16* src = proj + (size_t)tok0 * DIN + 2048 + F.tid;
            unsigned w[32];
#pragma unroll
            for (int i = 0; i < 32; ++i) { const unsigned lo = src[(size_t)(2 * i) * DIN], hi = src[(size_t)(2 * i + 1) * DIN]; w[i] = lo | (hi << 16); }
            bf16* dst = Vt + ((size_t)(b * NH * DV + F.tid)) * SEQ + s0;
#pragma unroll
            for (int i = 0; i < 8; ++i) { u32x4 o; o.x = w[4 * i]; o.y = w[4 * i + 1]; o.z = w[4 * i + 2]; o.w = w[4 * i + 3]; *(GAS u32x4*)(dst + 8 * i) = o; }
        }
    }
}

__device__ __forceinline__ void p3_conv(Frame& F) {
    const bf16* proj = (const bf16*)(F.ws + WS_PROJ); bf16* mixed = (bf16*)(F.ws + WS_MIX);
    LAS float* ybuf = (LAS float*)F.lds;
    const int c = F.tid;
    float cw[CWID];
#pragma unroll
    for (int j = 0; j < CWID; ++j) cw[j] = F.in[I_CONVW][j * DCONV + c];
    const float cb = F.in[I_CONVB][c];
    for (int tile = F.vcu; tile < NTOK / 64; tile += F.G) {
        const int b = tile / (SEQ / 64), t0 = (tile % (SEQ / 64)) * 64;
        float win[CWID];
#pragma unroll
        for (int j = 0; j < CWID; ++j) win[j] = 0.f;
        const bf16* base = proj + (size_t)(b * SEQ) * DIN + c;
        for (int o = 0; o < 4; ++o) {
#pragma unroll
            for (int i = 0; i < CWID; ++i) {
                const int s = o * CWID + i;
                if (s < 94) {
                    const int tt = t0 - 30 + s;
                    float u = 0.f;
                    if (tt >= 0) { const float a = bf2f(base[(size_t)tt * DIN]), g = bf2f(base[(size_t)tt * DIN + DCONV]); u = a * __builtin_amdgcn_rcpf(1.0f + __builtin_amdgcn_exp2f(-LOG2E * g)); }
                    win[i] = u;
                    if (s >= 30) {
                        float y = cb;
#pragma unroll
                        for (int j = 0; j < CWID; ++j) y += cw[j] * win[(i + 1 + j) % CWID];
                        ybuf[(s - 30) * DCONV + c] = y;
                    }
                }
            }
        }
        LDS_WAIT(); __syncthreads();
        {
            const int ch = F.lane * 8;
            const f32x4 g0 = *(const GAS f32x4*)(F.in[I_LNG] + ch), g1 = *(const GAS f32x4*)(F.in[I_LNG] + ch + 4);
            const f32x4 b0 = *(const GAS f32x4*)(F.in[I_LNB] + ch), b1 = *(const GAS f32x4*)(F.in[I_LNB] + ch + 4);
#pragma unroll 2
            for (int tt = 0; tt < 8; ++tt) {
                const int tl = F.wave * 8 + tt;
                const f32x4 y0 = *(const LAS f32x4*)(ybuf + tl * DCONV + ch), y1 = *(const LAS f32x4*)(ybuf + tl * DCONV + ch + 4);
                const float mean = wave_sum((y0.x + y0.y) + (y0.z + y0.w) + (y1.x + y1.y) + (y1.z + y1.w)) * (1.0f / DCONV);
                const f32x4 d0 = y0 - mean, d1 = y1 - mean;
                const float var = wave_sum((d0.x * d0.x + d0.y * d0.y) + (d0.z * d0.z + d0.w * d0.w) + (d1.x * d1.x + d1.y * d1.y) + (d1.z * d1.z + d1.w * d1.w)) * (1.0f / DCONV);
                const float rstd = 1.0f / sqrtf(var + EPS);
                float z[8];
#pragma unroll
                for (int i = 0; i < 4; ++i) { z[i] = d0[i] * rstd * g0[i] + b0[i]; z[4 + i] = d1[i] * rstd * g1[i] + b1[i]; }
#pragma unroll
                for (int i = 0; i < 8; ++i) z[i] = z[i] * __builtin_amdgcn_rcpf(1.0f + __builtin_amdgcn_exp2f(-LOG2E * z[i]));
                u32x4 w; w.x = pk2(z[0], z[1]); w.y = pk2(z[2], z[3]); w.z = pk2(z[4], z[5]); w.w = pk2(z[6], z[7]);
                *(GAS u32x4*)(mixed + (size_t)(b * SEQ + t0 + tl) * DM + ch) = w;
            }
        }
        LDS_WAIT(); __syncthreads();
    }
}

__device__ __forceinline__ int t5_bucket(int rel) {
    const int n = rel < 0 ? -rel : rel; int bkt;
    if (n < 8) bkt = n; else { const int k = 31 - __builtin_clz((unsigned)(n * n) >> 6); bkt = 8 + k; if (bkt > 15) bkt = 15; }
    return bkt + (rel > 0 ? 16 : 0);
}
constexpr int AT_STAGE = 32768;
constexpr int AT_XBUF = 65536;
__device__ __forceinline__ int swap23(int r) { return (r & ~12) | ((r & 4) << 1) | ((r & 8) >> 1); }

__device__ __forceinline__ void attn_unit(Frame& F, int b, int h, int qb, float lam) {
    const bf16* proj = (const bf16*)(F.ws + WS_PROJ); const bf16* Vt = (const bf16*)(F.ws + WS_VT); bf16* mixed = (bf16*)(F.ws + WS_MIX);
    const int lane = F.lane, wid = F.wave, m = wid & 1, rg = wid >> 1, r32 = lane & 31, hi = lane >> 5;
    const int qrow = qb * 128 + 32 * rg + r32, cq = 2 * qb + (rg >> 1), ntile = 2 * qb + 2;
    LAS unsigned char* lds = F.lds;
    const LAS float* lut = (const LAS float*)(F.lds + LDSX_OFF);
    bf16x8 qf[4];
    { const bf16* qp = proj + (size_t)(b * SEQ + qrow) * DIN + 1024 + h * 128 + m * 64 + hi * 8;
#pragma unroll
      for (int d0 = 0; d0 < 4; ++d0) qf[d0] = *(const GAS bf16x8*)(qp + d0 * 16); }
    const int prow = F.tid >> 3, pch = F.tid & 7;
    const bf16* ksrc0 = proj + (size_t)(b * SEQ + prow) * DIN + 1536 + h * 128 + pch * 8;
    const bf16* vsrc0 = Vt + (size_t)((b * NH + h) * DV + prow) * SEQ + pch * 8;
    const int kslot = swap23(prow);
    const unsigned kdst = (unsigned)(kslot * 128 + ((pch ^ ((kslot >> 1) & 7)) << 4));
    const unsigned vdst = (unsigned)(prow * 128 + ((pch ^ ((prow >> 1) & 7)) << 4));
    const int swz = (r32 >> 1) & 7;
    unsigned foff[4];
#pragma unroll
    for (int s = 0; s < 4; ++s) foff[s] = (unsigned)(r32 * 128 + (((2 * s + hi) ^ swz) << 4));
    u32x4 pre[4];
#define AT_LOAD(j) do { pre[0] = *(const GAS u32x4*)(ksrc0 + (size_t)(j) * 64 * DIN); pre[1] = *(const GAS u32x4*)(ksrc0 + (size_t)(j) * 64 * DIN + 64); \
        pre[2] = *(const GAS u32x4*)(vsrc0 + (j) * 64); pre[3] = *(const GAS u32x4*)(vsrc0 + (size_t)64 * SEQ + (j) * 64); } while (0)
#define AT_WRITE(st) do { LAS unsigned char* sb = lds + (st) * AT_STAGE; *(LAS u32x4*)(sb + kdst) = pre[0]; *(LAS u32x4*)(sb + 8192 + kdst) = pre[1]; \
        *(LAS u32x4*)(sb + 16384 + vdst) = pre[2]; *(LAS u32x4*)(sb + 16384 + 8192 + vdst) = pre[3]; } while (0)
    f32x16 o[4];
#pragma unroll
    for (int i = 0; i < 4; ++i)
#pragma unroll
        for (int r = 0; r < 16; ++r) o[i][r] = 0.f;
    float mrun = -1e30f, lrun = 0.f;
    const float c15 = lut[0];
    AT_LOAD(0); AT_WRITE(0); LDS_WAIT(); __syncthreads();
    for (int j = 0; j < ntile; ++j) {
        if (j + 1 < ntile) AT_LOAD(j + 1);
        if (j <= cq) {
            const LAS unsigned char* sb = lds + (j & 1) * AT_STAGE;
            const LAS unsigned char* kb = sb + m * 8192;
            const LAS unsigned char* vb = sb + 16384;
            f32x16 sa[2];
            if (cq - j >= 3) {
#pragma unroll
                for (int r = 0; r < 16; ++r) { sa[0][r] = c15; sa[1][r] = c15; }
            } else {
                const int bi = 64 * (j - cq) + 8 * hi - 32 * (rg & 1) - r32 + 191;
#pragma unroll
                for (int hh = 0; hh < 2; ++hh)
#pragma unroll
                    for (int r = 0; r < 16; ++r) sa[hh][r] = lut[bi + 32 * hh + 16 * (r >> 3) + (r & 7)];
            }
#pragma unroll
            for (int hh = 0; hh < 2; ++hh)
#pragma unroll
                for (int d0 = 0; d0 < 4; ++d0) { const bf16x8 kf = *(const LAS bf16x8*)(kb + hh * 4096 + foff[d0]); sa[hh] = __builtin_amdgcn_mfma_f32_32x32x16_bf16(kf, qf[d0], sa[hh], 0, 0, 0); }
            float mt = sa[0][0];
#pragma unroll
            for (int r = 1; r < 16; ++r) mt = fmaxf(mt, sa[0][r]);
#pragma unroll
            for (int r = 0; r < 16; ++r) mt = fmaxf(mt, sa[1][r]);
            mt = fmaxf(mt, __shfl_xor(mt, 32));
            const float mnew = fmaxf(mrun, mt), alpha = __builtin_amdgcn_exp2f(mrun - mnew);
            float ls = 0.f;
#pragma unroll
            for (int hh = 0; hh < 2; ++hh)
#pragma unroll
                for (int r = 0; r < 16; ++r) { const float p = __builtin_amdgcn_exp2f(sa[hh][r] - mnew); sa[hh][r] = p; ls += p; }
            lrun = lrun * alpha + ls; mrun = mnew;
#pragma unroll
            for (int i = 0; i < 4; ++i)
#pragma unroll
                for (int r = 0; r < 16; ++r) o[i][r] *= alpha;
#pragma unroll
            for (int s = 0; s < 4; ++s) {
                u32x4 pw;
#pragma unroll
                for (int i = 0; i < 4; ++i) pw[i] = pk2(sa[s >> 1][8 * (s & 1) + 2 * i], sa[s >> 1][8 * (s & 1) + 2 * i + 1]);
                const bf16x8 pf = __builtin_bit_cast(bf16x8, pw);
#pragma unroll
                for (int db = 0; db < 4; ++db) { const bf16x8 vf = *(const LAS bf16x8*)(vb + db * 4096 + foff[s]); o[db] = __builtin_amdgcn_mfma_f32_32x32x16_bf16(vf, pf, o[db], 0, 0, 0); }
            }
        }
        if (j + 1 < ntile) AT_WRITE((j + 1) & 1);
        LDS_WAIT(); __syncthreads();
    }
#undef AT_LOAD
#undef AT_WRITE
    const float ltot = lrun + __shfl_xor(lrun, 32);
    const float inv = 1.0f / ltot;
    LAS float* xb = (LAS float*)(lds + AT_XBUF) + rg * 4096;
    if (m == 1) {
        const float f = inv * lam;
#pragma unroll
        for (int db = 0; db < 4; ++db)
#pragma unroll
            for (int r = 0; r < 16; ++r) xb[(db * 16 + r) * 64 + lane] = o[db][r] * f;
    }
    LDS_WAIT(); __syncthreads();
    if (m == 0) {
        float ss = 0.f;
#pragma unroll
        for (int db = 0; db < 4; ++db)
#pragma unroll
            for (int r = 0; r < 16; ++r) { const float d = o[db][r] * inv - xb[(db * 16 + r) * 64 + lane]; o[db][r] = d; ss += d * d; }
        ss += __shfl_xor(ss, 32);
        const float rstd = 0.8f / sqrtf(ss * (1.0f / DV) + EPS);
        bf16* orow = mixed + (size_t)(b * SEQ + qrow) * DM + DCONV + h * DV;
#pragma unroll
        for (int db = 0; db < 4; ++db)
#pragma unroll
            for (int r4 = 0; r4 < 4; ++r4) {
                const int d = 32 * db + 8 * r4 + 4 * hi;
                const f32x4 g = *(const GAS f32x4*)(F.in[I_SUBG] + d);
                u32x2 w; w.x = pk2(o[db][4 * r4] * rstd * g.x, o[db][4 * r4 + 1] * rstd * g.y); w.y = pk2(o[db][4 * r4 + 2] * rstd * g.z, o[db][4 * r4 + 3] * rstd * g.w);
                *(GAS u32x2*)(orow + d) = w;
            }
    }
}

__device__ __forceinline__ void p3_attn(Frame& F) {
    float lam;
    { const float* lq = F.in[I_LAMQK]; const float a = lq[F.lane] * lq[64 + F.lane], c = lq[128 + F.lane] * lq[192 + F.lane];
      lam = __expf(wave_sum(a)) - __expf(wave_sum(c)) + 0.2f; }
    LAS float* lut = (LAS float*)(F.lds + LDSX_OFF);
    for (int u = F.vcu; u < 256; u += F.G) {
        const int bh = u >> 3, s = u & 7, b = bh >> 2, h = bh & 3;
        __syncthreads();
        if (F.tid < 256) { const int rel = F.tid - 191; lut[F.tid] = F.in[I_RELB][t5_bucket(rel) * NH + h] * LOG2E; }
        LDS_WAIT(); __syncthreads();
        attn_unit(F, b, h, s, lam);
        attn_unit(F, b, h, 15 - s, lam);
    }
}

__device__ __forceinline__ void p5_router(Frame& F) {
    const float* hsrc = F.out; bf16* HN = (bf16*)(F.ws + WS_XN);
    int* list = (int*)(F.ws + WS_LIST); float* gates = (float*)(F.ws + WS_GATES);
    unsigned* cnt = (unsigned*)(F.ws + WS_CTL) + CW_CNT;
    LAS float* hbuf = (LAS float*)F.lds;
    LAS float* pbuf = (LAS float*)(F.lds + 65536);
    LAS int* hist = (LAS int*)(F.lds + LDSX_OFF);
    LAS int* basel = hist + 32;
    LAS int* pendE = hist + 64;
    LAS float* pendG = (LAS float*)(hist + 320);
    const int e = F.tid & 31, ks = F.tid >> 5, lane = F.lane;
    float wreg[64];
#pragma unroll
    for (int i = 0; i < 64; ++i) wreg[i] = F.in[I_RW][(size_t)(ks * 64 + i) * NE + e];
    const float rb = F.in[I_RB][e];
    for (int tile = F.vcu; tile < NTOK / 64; tile += F.G) {
        const int tok0 = tile * 64;
        __syncthreads();
        if (F.tid < 32) hist[F.tid] = 0;
        for (int bt = 0; bt < 4; ++bt) {
#pragma unroll
            for (int tt = 0; tt < 2; ++tt) {
                const int tl = F.wave * 2 + tt, tok = tok0 + bt * 16 + tl;
                const GAS f32x4* xr = (const GAS f32x4*)(hsrc + (size_t)tok * DM) + lane;
                f32x4 v[4]; float s = 0.f;
#pragma unroll
                for (int j = 0; j < 4; ++j) { v[j] = xr[64 * j]; s += (v[j].x * v[j].x + v[j].y * v[j].y) + (v[j].z * v[j].z + v[j].w * v[j].w); }
                const float rstd = 1.0f / sqrtf(wave_sum(s) * (1.f / DM) + EPS);
                GAS u32x2* o8 = (GAS u32x2*)(HN + (size_t)tok * DM) + lane;
#pragma unroll
                for (int j = 0; j < 4; ++j) { const f32x4 gg = *((const GAS f32x4*)F.in[I_G2] + lane + 64 * j); const f32x4 hn = v[j] * rstd * gg;
                    u32x2 w; w.x = pk2(hn.x, hn.y); w.y = pk2(hn.z, hn.w); o8[64 * j] = w;
                    *(LAS f32x4*)(hbuf + tl * DM + 4 * lane + 256 * j) = hn; }
            }
            LDS_WAIT(); __syncthreads();
            for (int tl = 0; tl < 16; ++tl) {
                const LAS f32x4* hp = (const LAS f32x4*)(hbuf + tl * DM + ks * 64);
                float a0 = 0.f, a1 = 0.f;
#pragma unroll
                for (int i = 0; i < 16; ++i) { const f32x4 hv = hp[i]; a0 += hv.x * wreg[4 * i] + hv.z * wreg[4 * i + 2]; a1 += hv.y * wreg[4 * i + 1] + hv.w * wreg[4 * i + 3]; }
                pbuf[(tl * 16 + ks) * 32 + e] = a0 + a1;
            }
            LDS_WAIT(); __syncthreads();
            {
                const int tl = F.wave * 2 + (lane >> 5), el = lane & 31;
                float v = rb;
#pragma unroll
                for (int k = 0; k < 16; ++k) v += pbuf[(tl * 16 + k) * 32 + el];
                float topv[4]; int topi[4];
#pragma unroll
                for (int k = 0; k < 4; ++k) {
                    float bv = v; int bi = el;
#pragma unroll
                    for (int off = 16; off >= 1; off >>= 1) { const float ov = __shfl_xor(bv, off); const int oi = __shfl_xor(bi, off); if (ov > bv || (ov == bv && oi < bi)) { bv = ov; bi = oi; } }
                    topv[k] = bv; topi[k] = bi; if (el == bi) v = -INFINITY;
                }
                const float e1 = __expf(topv[1] - topv[0]), e2 = __expf(topv[2] - topv[0]), e3 = __expf(topv[3] - topv[0]);
                const float inv = 1.0f / (1.0f + e1 + e2 + e3);
                if (el < 4) {
                    const int ee = el == 0 ? topi[0] : el == 1 ? topi[1] : el == 2 ? topi[2] : topi[3];
                    const float gg = (el == 0 ? 1.0f : el == 1 ? e1 : el == 2 ? e2 : e3) * inv;
                    const int slot = atomicAdd((int*)&hist[ee], 1);
                    const int idx = (bt * 16 + tl) * 4 + el;
                    pendE[idx] = ee | (slot << 8); pendG[idx] = gg;
                }
            }
            LDS_WAIT(); __syncthreads();
        }
        if (F.tid < 32) basel[F.tid] = (int)__hip_atomic_fetch_add(cnt + 32 * F.tid, (unsigned)hist[F.tid], RLX_AGENT);
        LDS_WAIT(); __syncthreads();
        if (F.tid < 256) {
            const int pe = pendE[F.tid], ee = pe & 0xff, slot = pe >> 8; const int entry = (tok0 + (F.tid >> 2)) * 4 + (F.tid & 3);
            list[ee * LIST_CAP + basel[ee] + slot] = entry; gates[entry] = pendG[F.tid];
        }
    }
}

__device__ __forceinline__ void p8_combine(Frame& F) {
    const bf16* yb = (const bf16*)(F.ws + WS_YB);
    const int gt = F.vcu * (NWAVES * 64) + F.tid, NGT = F.G * NWAVES * 64;
    for (int i = gt; i < NTOK * (DM / 8); i += NGT) {
        const int tok = i >> 7, c8 = (i & 127) * 8;
        float* hp = F.out + (size_t)tok * DM + c8;
        f32x4 a = *(const GAS f32x4*)hp, b = *(const GAS f32x4*)(hp + 4);
#pragma unroll
        for (int k = 0; k < 4; ++k) { const u32x4 w = *(const GAS u32x4*)(yb + ((size_t)tok * 4 + k) * DM + c8);
            a.x += bflo(w.x); a.y += bfhi(w.x); a.z += bflo(w.y); a.w += bfhi(w.y); b.x += bflo(w.z); b.y += bfhi(w.z); b.z += bflo(w.w); b.w += bfhi(w.w); }
        *(GAS f32x4*)hp = a; *(GAS f32x4*)(hp + 4) = b;
    }
}

__device__ __forceinline__ void moe_table(Frame& F, int& pre_lane, int& cnt_lane, int& total_rb) {
    const unsigned* cnt = (const unsigned*)(F.ws + WS_CTL) + CW_CNT;
    int c = 0, rbn = 0;
    if (F.lane < 32) { c = (int)__hip_atomic_load(cnt + 32 * F.lane, RLX_AGENT); rbn = (c + 255) >> 8; }
    int p = rbn;
#pragma unroll
    for (int o = 1; o < 32; o <<= 1) { const int t = __shfl_up(p, o); if ((F.lane & 31) >= o) p += t; }
    total_rb = __builtin_amdgcn_readlane(p, 31);
    pre_lane = F.lane < 32 ? p : 0x7fffffff; cnt_lane = c;
}

constexpr int N_PHASES = 9;
__global__ void __launch_bounds__(NWAVES * 64, 2) fwd(Args args) {
    extern __shared__ __attribute__((aligned(16))) unsigned char lds_raw[];
    Frame F;
    F.lds = (LAS unsigned char*)lds_raw;
    F.tid = threadIdx.x; F.lane = F.tid & 63; F.wave = __builtin_amdgcn_readfirstlane(F.tid >> 6);
    F.G = gridDim.x; { const int bx = blockIdx.x; F.vcu = (F.G % 8 == 0) ? (bx % 8) * (F.G / 8) + bx / 8 : bx; }
    F.in = args.in; F.out = args.out; F.ws = args.ws;
    volatile LAS unsigned* MISC = (volatile LAS unsigned*)(F.lds + MISC_OFF);
    for (int u = F.tid; u < (LDS_BYTES - MISC_OFF) / 4; u += NWAVES * 64) MISC[u] = 0u;
    __syncthreads();
    unsigned* ctl = (unsigned*)(F.ws + WS_CTL);
#if MK_ONE_LAUNCH
    XcdBarrier bar = xcd_barrier_post(ctl + CW_BAR, MISC + 8);
#define GRID_BAR() xcd_barrier(bar)
#else
#define GRID_BAR() do { } while (0)
#endif
    const int lo = args.ph_lo, hi = args.ph_hi;
#define IN(k) (lo <= (k) && (k) < hi)
#define BOTH(k) (IN(k) && IN((k) + 1))

    if (IN(0)) { p0_prologue(F); if (BOTH(0)) GRID_BAR(); }

    if (IN(1)) {
        pg8::DenseSched S; S.init(F.ws + WS_XN, F.ws + WS_WIN, NTOK, DIN, DM, F.G, (int)blockIdx.x);
        pg8::EpiBf16 E{(bf16*)(F.ws + WS_PROJ), DIN};
        pg8::gemm_phase<pg8::EpiBf16, pg8::DenseSched, true, true>(F.lds, DM, S, E);
        if (BOTH(1)) GRID_BAR();
    }
    if (IN(2)) { p2_prep(F); if (BOTH(2)) GRID_BAR(); }
    if (IN(3)) { p3_conv(F); p3_attn(F); if (BOTH(3)) GRID_BAR(); }
    if (IN(4)) {
        pg8::DenseSched S; S.init(F.ws + WS_MIX, F.ws + WS_WOUT, NTOK, DM, DM, F.G, (int)blockIdx.x);
        pg8::EpiResF32 E{F.in[I_X], F.out, DM};
        pg8::gemm_phase<pg8::EpiResF32, pg8::DenseSched, true, true>(F.lds, DM, S, E);
        if (BOTH(4)) GRID_BAR();
    }
    if (IN(5)) { p5_router(F); if (BOTH(5)) GRID_BAR(); }
    if (IN(6)) {
        int pre, cn, trb; moe_table(F, pre, cn, trb);
        pg8::MoeSched S; S.A = (const char*)(F.ws + WS_XN); S.Bt = (const char*)(F.ws + WS_WGU); S.list = (const int*)(F.ws + WS_LIST); S.K = DM; S.ncb = 8; S.total = trb * 8;
        S.G = F.G; S.c = (int)blockIdx.x; S.pre_lane = pre; S.cnt_lane = cn; S.gather = true; S.estride = (size_t)2 * DFF * DM * 2;
        pg8::EpiSwiglu E{(bf16*)(F.ws + WS_ACT), F.in[I_BGU]};
        pg8::gemm_phase<pg8::EpiSwiglu, pg8::MoeSched, true, true>(F.lds, DM, S, E);
        if (BOTH(6)) GRID_BAR();
    }
    if (IN(7)) {
        int pre, cn, trb; moe_table(F, pre, cn, trb);
        pg8::MoeSched S; S.A = (const char*)(F.ws + WS_ACT); S.Bt = (const char*)(F.ws + WS_WD); S.list = (const int*)(F.ws + WS_LIST); S.K = DFF; S.ncb = 4; S.total = trb * 4;
        S.G = F.G; S.c = (int)blockIdx.x; S.pre_lane = pre; S.cnt_lane = cn; S.gather = false; S.estride = (size_t)DM * DFF * 2;
        pg8::EpiDown E{(bf16*)(F.ws + WS_YB), F.in[I_BD], (const int*)(F.ws + WS_LIST), (const float*)(F.ws + WS_GATES)};
        pg8::gemm_phase<pg8::EpiDown, pg8::MoeSched, true, true>(F.lds, DFF, S, E);
        if (BOTH(7)) GRID_BAR();
    }
    if (IN(8)) { p8_combine(F); }
#undef IN
#undef BOTH
}

extern "C" void kernel_launch(void* const* d_in, const int* in_sizes, int n_in, void* d_out, int out_size, void* d_ws, size_t ws_size, hipStream_t stream) {
    static int grid = 0;
    if (grid == 0) {
        if (n_in != 20 || in_sizes[0] != NTOK * DM || out_size != NTOK * DM || ws_size < WS_END) { fprintf(stderr, "kernel_launch: unexpected shapes (n_in %d, in0 %d, out %d, ws %zu)\n", n_in, n_in > 0 ? in_sizes[0] : -1, out_size, ws_size); grid = -1; return; }
        int dev = 0, cus = 0, per_cu = 0;
        if (hipGetDevice(&dev) != hipSuccess || hipDeviceGetAttribute(&cus, hipDeviceAttributeMultiprocessorCount, dev) != hipSuccess) { grid = -1; return; }
        if (hipFuncSetAttribute((const void*)fwd, hipFuncAttributeMaxDynamicSharedMemorySize, LDS_BYTES) != hipSuccess) { fprintf(stderr, "kernel_launch: hipFuncSetAttribute failed\n"); grid = -1; return; }
        if (hipOccupancyMaxActiveBlocksPerMultiprocessor(&per_cu, (const void*)fwd, NWAVES * 64, LDS_BYTES) != hipSuccess || per_cu < 1) { fprintf(stderr, "kernel_launch: occupancy query reports %d\n", per_cu); }
        (void)hipGetLastError();
        grid = cus;
    }
    if (grid < 0) return;
    (void)hipMemsetAsync((char*)d_ws + WS_CTL, 0, CTL_ZERO_BYTES, stream);
    Args a{};
    for (int i = 0; i < 20; ++i) a.in[i] = (const float*)d_in[i];
    a.out = (float*)d_out; a.ws = (unsigned char*)d_ws;
#if MK_ONE_LAUNCH
    a.ph_lo = 0; a.ph_hi = N_PHASES;
    hipLaunchKernelGGL(fwd, dim3(grid), dim3(NWAVES * 64), LDS_BYTES, stream, a);
#else
    for (int p = 0; p < N_PHASES; ++p) { a.ph_lo = p; a.ph_hi = p + 1; hipLaunchKernelGGL(fwd, dim3(grid), dim3(NWAVES * 64), LDS_BYTES, stream, a); }
#endif
}
```

```cpp
#include <hip/hip_runtime.h>
#include <cstdio>
#include <cstdint>

#ifndef PROBE_DUP
#define PROBE_DUP -1
#endif
#ifndef PROBE_SUB
#define PROBE_SUB 0
#endif
#ifndef PROBE_REP
#define PROBE_REP 1
#endif
#ifndef MK_ONE_LAUNCH
#define MK_ONE_LAUNCH 1
#endif

#define GAS __attribute__((address_space(1)))
#define LAS __attribute__((address_space(3)))
typedef unsigned short bf16;
typedef short bf16x8 __attribute__((ext_vector_type(8)));
typedef float f32x4 __attribute__((ext_vector_type(4)));
typedef float f32x2 __attribute__((ext_vector_type(2)));
typedef float f32x16 __attribute__((ext_vector_type(16)));
typedef unsigned u32x4 __attribute__((ext_vector_type(4)));
typedef unsigned u32x2 __attribute__((ext_vector_type(2)));

constexpr int NB = 8, SEQ = 2048, DM = 1024, NTOK = NB * SEQ;
constexpr int DCONV = 512, CWID = 31, NH = 4, DH = 64, DV = 128, DATT = 512, DIN = 2560;
constexpr int NE = 32, TOPK = 4, DFF = 1024;
constexpr float EPS = 1e-5f;
constexpr float LOG2E = 1.4426950408889634f;
constexpr int LIST_CAP = NTOK;
constexpr int MAX_RB = NTOK * TOPK / 256 + NE;

constexpr size_t MiB = 1u << 20;
constexpr size_t WS_CTL = 0, CTL_ZERO_BYTES = 64 * 1024;
constexpr size_t WS_WIN = 2 * MiB;
constexpr size_t WS_WOUT = 8 * MiB;
constexpr size_t WS_WRT = 12 * MiB;
constexpr size_t WS_WGU = 16 * MiB;
constexpr size_t WS_WD = 144 * MiB;
constexpr size_t WS_HN8 = 176 * MiB;
constexpr size_t WS_XN = 208 * MiB;
constexpr size_t WS_U = 240 * MiB;
constexpr size_t WS_QK = 272 * MiB;
constexpr size_t WS_VT = 320 * MiB;
constexpr size_t WS_MIX = 336 * MiB;
constexpr size_t WS_LIST = 368 * MiB;
constexpr size_t WS_GATES = 370 * MiB;
constexpr size_t WS_ACT = 372 * MiB;
constexpr size_t WS_YB = 516 * MiB;
constexpr size_t WS_END = 644 * MiB;
constexpr int CW_BAR = 4096;
constexpr int CW_CNT = 8192;

constexpr int RING_BYTES = 131072;
constexpr int LDSX_OFF = RING_BYTES;
constexpr int MISC_OFF = RING_BYTES + 8192;
constexpr int LDS_BYTES = 147456;
constexpr int NWAVES = 8;

#define LDS_WAIT() asm volatile("s_waitcnt lgkmcnt(0)" ::: "memory")
#define VM_WAIT() asm volatile("s_waitcnt vmcnt(0)" ::: "memory")
#define RLX_AGENT __ATOMIC_RELAXED, __HIP_MEMORY_SCOPE_AGENT

__device__ __forceinline__ unsigned f2bf(float f) { unsigned u = __builtin_bit_cast(unsigned, f); return (u + 0x7fffu + ((u >> 16) & 1u)) >> 16; }
typedef __bf16 bf16x2_t __attribute__((ext_vector_type(2)));
__device__ __forceinline__ unsigned pk2c(float lo, float hi) { const f32x2 v = {lo, hi}; return __builtin_bit_cast(unsigned, __builtin_convertvector(v, bf16x2_t)); }
__device__ __forceinline__ unsigned pk2(float lo, float hi) { unsigned r; asm volatile("v_cvt_pk_bf16_f32 %0, %1, %2" : "=v"(r) : "v"(lo), "v"(hi)); return r; }
__device__ __forceinline__ unsigned pk4_fp8(float a, float b, float c, float d) { unsigned r = 0; r = __builtin_amdgcn_cvt_pk_fp8_f32(a, b, r, false); r = __builtin_amdgcn_cvt_pk_fp8_f32(c, d, r, true); return r; }
constexpr float W8_SCALE = 32.0f, W8_INV = 1.0f / 32.0f, YB_SCALE = 4.0f, YB_INV = 1.0f / 4.0f;
__device__ __forceinline__ float bf2f(unsigned short b) { return __builtin_bit_cast(float, (unsigned)b << 16); }
__device__ __forceinline__ float bflo(unsigned w) { return __builtin_bit_cast(float, w << 16); }
__device__ __forceinline__ float bfhi(unsigned w) { return __builtin_bit_cast(float, w & 0xffff0000u); }
__device__ __forceinline__ float wave_sum(float v) {
#pragma unroll
    for (int o = 1; o < 64; o <<= 1) v += __shfl_xor(v, o);
    return v;
}

namespace pg8 {
constexpr int BM = 256, BK = 64, HALF = 128, HTB = HALF * BK * 2, STAGE_BYTES = 8 * HTB, NXCD = 8, WGM = 8;
__host__ __device__ __forceinline__ int lds_byte(int r, int c) { const int st = (r >> 4) * 2 + (c >> 5), rr = r & 15, cc = c & 31, ob = rr * 64 + cc * 2; return st * 1024 + (ob ^ (((ob >> 9) & 1) << 5)); }
__host__ __device__ __forceinline__ void stage_rc(int b, int& R, int& C) { const int st = b / 1024, sb = b % 1024, swz = sb ^ (((sb >> 9) & 1) << 5); R = (st >> 1) * 16 + swz / 64; C = (st & 1) * 32 + (swz % 64) / 2; }
__host__ __device__ __forceinline__ int perm32(int rho) { const int n = rho >> 4, i = rho & 15; return 8 * (i >> 2) + 4 * n + (i & 3); }

struct Unit { int pm, pn, e, rb, nvalid; };

struct DenseSched {
    const char* A; const char* Bt; int K; int nM, nN, nwg, G, c; int i0, i1;
    __device__ __forceinline__ void init(const void* A_, const void* Bt_, int M, int N, int K_, int G_, int c_) { A = (const char*)A_; Bt = (const char*)Bt_; K = K_; nM = M / BM; nN = N / BM; nwg = nM * nN; G = G_; c = c_; i0 = 0; i1 = 1 << 20; }
    __device__ __forceinline__ bool next(int i_, Unit& u) const {
        const int i = i_ + i0; if (i >= i1) return false;
        const long L = (long)i * G + c; if (L >= nwg) return false;
        int wgid = (int)L; { const int q = nwg / NXCD, r = nwg % NXCD, xcd = wgid % NXCD, off = wgid / NXCD; wgid = (xcd < r ? xcd * (q + 1) : r * (q + 1) + (xcd - r) * q) + off; }
        const int nig = WGM * nN, gid = wgid / nig, fm = gid * WGM, gsz = (nM - fm) < WGM ? (nM - fm) : WGM;
        u.pm = fm + ((wgid % nig) % gsz); u.pn = (wgid % nig) / gsz; u.e = 0; u.rb = 0; u.nvalid = 256; return true;
    }
    __device__ __forceinline__ const char* a_base() const { return A; }
    __device__ __forceinline__ void a_offsets(const Unit& u, const int (&Rr)[2], const int (&Cc)[2], unsigned (&o)[2][2]) const {
#pragma unroll
        for (int h = 0; h < 2; ++h)
#pragma unroll
            for (int i = 0; i < 2; ++i) o[h][i] = (unsigned)((u.pm * BM + h * HALF + Rr[i]) * K + Cc[i]) * 2u;
    }
    __device__ __forceinline__ const char* b_ptr(const Unit& u) const { return Bt + (size_t)u.pn * BM * K * 2; }
};

struct MoeSched {
    const char* A; const char* Bt; const int* list; int K; int ncb; int total; int G, c; int pre_lane, cnt_lane; bool gather; size_t estride;
    __device__ __forceinline__ bool next(int i, Unit& u) const {
        const int L = i * G + c; if (L >= total) return false;
        const int R = L / ncb, cb = L - R * ncb;
        const unsigned long long m = __ballot(R >= pre_lane);
        const int e = __popcll(m);
        const int prev = e ? __builtin_amdgcn_readlane(pre_lane, e - 1) : 0;
        const int cnt = __builtin_amdgcn_readlane(cnt_lane, e);
        u.pm = R; u.pn = cb; u.e = e; u.rb = R - prev; const int left = cnt - u.rb * 256; u.nvalid = left < 256 ? left : 256; return true;
    }
    __device__ __forceinline__ const char* a_base() const { return A; }
    __device__ __forceinline__ void a_offsets(const Unit& u, const int (&Rr)[2], const int (&Cc)[2], unsigned (&o)[2][2]) const {
#pragma unroll
        for (int h = 0; h < 2; ++h)
#pragma unroll
            for (int i = 0; i < 2; ++i) {
                const int r = h * HALF + Rr[i]; int row;
                if (gather) { row = 0; if (r < u.nvalid) row = list[u.e * LIST_CAP + u.rb * 256 + r] >> 2; }
                else row = u.pm * BM + r;
                o[h][i] = (unsigned)(row * K + Cc[i]) * 2u;
            }
    }
    __device__ __forceinline__ const char* b_ptr(const Unit& u) const { return Bt + (size_t)u.e * estride + (size_t)u.pn * BM * K * 2; }
};

struct EpiInProj {
    static constexpr bool PERM = true;
    bf16* U; bf16* QK; const float* qg; const float* kg;
    __device__ __forceinline__ void operator()(const f32x4 (&acc)[2][2][4][2], const Unit& u, int wr, int wc, int fr, int fq) const {
        const int row0 = u.pm * BM + wr * 64 + fr;
        if (u.pn < 4) {
            const int col0 = u.pn * 128 + wc * 32 + 8 * fq;
#pragma unroll
            for (int ai = 0; ai < 2; ++ai)
#pragma unroll
                for (int m = 0; m < 4; ++m) {
                    float o[8];
#pragma unroll
                    for (int n = 0; n < 2; ++n)
#pragma unroll
                        for (int i = 0; i < 4; ++i) { const float a = acc[ai][0][m][n][i], g = acc[ai][1][m][n][i]; o[4 * n + i] = a * __builtin_amdgcn_rcpf(1.0f + __builtin_amdgcn_exp2f(-LOG2E * g)); }
                    u32x4 w; w.x = pk2(o[0], o[1]); w.y = pk2(o[2], o[3]); w.z = pk2(o[4], o[5]); w.w = pk2(o[6], o[7]);
                    *(u32x4*)(U + (size_t)(row0 + ai * HALF + m * 16) * DCONV + col0) = w;
                }
        } else {
            const bool isq = u.pn < 6; const float sc = isq ? 0.125f * LOG2E : 1.0f;
            const float* gp = (isq ? qg : kg) + (wc & 1) * 64 + 8 * fq;
            f32x4 gv[2][2];
#pragma unroll
            for (int bj = 0; bj < 2; ++bj)
#pragma unroll
                for (int n = 0; n < 2; ++n) gv[bj][n] = *(const f32x4*)(gp + 32 * bj + 4 * n);
            const int col0 = (u.pn - 4) * 256 + wc * 64 + 8 * fq;
#pragma unroll
            for (int ai = 0; ai < 2; ++ai)
#pragma unroll
                for (int m = 0; m < 4; ++m) {
                    float ss = 0.f;
#pragma unroll
                    for (int bj = 0; bj < 2; ++bj)
#pragma unroll
                        for (int n = 0; n < 2; ++n) { const f32x4 v = acc[ai][bj][m][n]; ss += (v[0] * v[0] + v[1] * v[1]) + (v[2] * v[2] + v[3] * v[3]); }
                    ss += __shfl_xor(ss, 16); ss += __shfl_xor(ss, 32);
                    const float rstd = sc / sqrtf(ss * (1.0f / 64.0f) + EPS);
                    bf16* rowp = QK + (size_t)(row0 + ai * HALF + m * 16) * DM + col0;
#pragma unroll
                    for (int bj = 0; bj < 2; ++bj) { const f32x4 v0 = acc[ai][bj][m][0] * gv[bj][0] * rstd, v1 = acc[ai][bj][m][1] * gv[bj][1] * rstd;
                        u32x4 w; w.x = pk2(v0[0], v0[1]); w.y = pk2(v0[2], v0[3]); w.z = pk2(v1[0], v1[1]); w.w = pk2(v1[2], v1[3]);
                        *(u32x4*)(rowp + 32 * bj) = w; }
                }
        }
    }
};
struct EpiVt {
    static constexpr bool PERM = true;
    bf16* Vt;
    __device__ __forceinline__ void operator()(const f32x4 (&acc)[2][2][4][2], const Unit& u, int wr, int wc, int fr, int fq) const {
        const int row0 = u.pm * BM + wr * 64 + fr; const int tok0 = u.pn * BM; const int b = tok0 / SEQ, s0 = (tok0 % SEQ) + wc * 32 + 8 * fq;
#pragma unroll
        for (int ai = 0; ai < 2; ++ai)
#pragma unroll
            for (int m = 0; m < 4; ++m) { bf16* rowp = Vt + ((size_t)b * DATT + row0 + ai * HALF + m * 16) * SEQ + s0;
#pragma unroll
                for (int bj = 0; bj < 2; ++bj) { const f32x4 v0 = acc[ai][bj][m][0], v1 = acc[ai][bj][m][1];
                    u32x4 w; w.x = pk2(v0[0], v0[1]); w.y = pk2(v0[2], v0[3]); w.z = pk2(v1[0], v1[1]); w.w = pk2(v1[2], v1[3]);
                    *(u32x4*)(rowp + bj * HALF) = w; } }
    }
};
struct EpiResBf16 {
    static constexpr bool PERM = true;
    const float* base; bf16* out; int ldc;
    __device__ __forceinline__ void operator()(const f32x4 (&acc)[2][2][4][2], const Unit& u, int wr, int wc, int fr, int fq) const {
        const int col0 = u.pn * BM + wc * 32 + 8 * fq;
#pragma unroll
        for (int ai = 0; ai < 2; ++ai)
#pragma unroll
            for (int m = 0; m < 4; ++m) { const size_t off = (size_t)(u.pm * BM + ai * HALF + wr * 64 + m * 16 + fr) * ldc + col0;
#pragma unroll
                for (int bj = 0; bj < 2; ++bj) { const f32x4 b0 = *(const f32x4*)(base + off + bj * HALF), b1 = *(const f32x4*)(base + off + bj * HALF + 4);
                    const f32x4 v0 = b0 + acc[ai][bj][m][0], v1 = b1 + acc[ai][bj][m][1];
                    u32x4 w; w.x = pk2(v0[0], v0[1]); w.y = pk2(v0[2], v0[3]); w.z = pk2(v1[0], v1[1]); w.w = pk2(v1[2], v1[3]);
                    *(u32x4*)(out + off + bj * HALF) = w; } }
    }
};
struct EpiSwiglu {
    static constexpr bool PERM = true;
    unsigned char* act; const float* bgu;
    __device__ __forceinline__ void operator()(const f32x4 (&acc)[2][2][4][2], const Unit& u, int wr, int wc, int fr, int fq) const {
        const int row0 = u.pm * BM + wr * 64 + fr; const int acol0 = u.pn * 128 + wc * 32 + 8 * fq;
        const float* bp = bgu + (size_t)u.e * 2048 + 2 * acol0;
        f32x4 bb[4];
#pragma unroll
        for (int i = 0; i < 4; ++i) bb[i] = *(const f32x4*)(bp + 4 * i);
        float bg[8], bl[8];
#pragma unroll
        for (int i = 0; i < 4; ++i) { bg[2 * i] = bb[i][0]; bl[2 * i] = bb[i][1] + 1.0f; bg[2 * i + 1] = bb[i][2]; bl[2 * i + 1] = bb[i][3] + 1.0f; }
#pragma unroll
        for (int ai = 0; ai < 2; ++ai)
#pragma unroll
            for (int m = 0; m < 4; ++m) {
                float o[8];
#pragma unroll
                for (int n = 0; n < 2; ++n)
#pragma unroll
                    for (int i = 0; i < 4; ++i) {
                        float g = acc[ai][0][m][n][i] * W8_INV + bg[4 * n + i], l1 = acc[ai][1][m][n][i] * W8_INV + bl[4 * n + i];
                        g = fminf(g, 7.0f); l1 = __builtin_amdgcn_fmed3f(l1, -6.0f, 8.0f);
                        const float sg = __builtin_amdgcn_rcpf(1.0f + __builtin_amdgcn_exp2f(-1.702f * LOG2E * g));
                        o[4 * n + i] = (g * l1) * sg;
                    }
                u32x2 w; w.x = pk4_fp8(o[0], o[1], o[2], o[3]); w.y = pk4_fp8(o[4], o[5], o[6], o[7]);
                *(u32x2*)(act + (size_t)(row0 + ai * HALF + m * 16) * DFF + acol0) = w;
            }
    }
};
struct EpiDown {
    static constexpr bool PERM = true;
    unsigned char* yb; const float* bd;
    __device__ __forceinline__ void operator()(const f32x4 (&acc)[2][2][4][2], const Unit& u, int wr, int wc, int fr, int fq) const {
        const int col0 = u.pn * BM + wc * 32 + 8 * fq; const int row0 = u.pm * BM + wr * 64 + fr;
        f32x4 bv[2][2];
#pragma unroll
        for (int bj = 0; bj < 2; ++bj)
#pragma unroll
            for (int n = 0; n < 2; ++n) bv[bj][n] = *(const f32x4*)(bd + (size_t)u.e * DM + col0 + bj * HALF + 4 * n) * YB_SCALE;
#pragma unroll
        for (int ai = 0; ai < 2; ++ai)
#pragma unroll
            for (int m = 0; m < 4; ++m) { unsigned char* rowp = yb + (size_t)(row0 + ai * HALF + m * 16) * DM + col0;
#pragma unroll
                for (int bj = 0; bj < 2; ++bj) { const f32x4 v0 = acc[ai][bj][m][0] * (W8_INV * YB_SCALE) + bv[bj][0], v1 = acc[ai][bj][m][1] * (W8_INV * YB_SCALE) + bv[bj][1];
                    u32x2 w; w.x = pk4_fp8(v0[0], v0[1], v0[2], v0[3]); w.y = pk4_fp8(v1[0], v1[1], v1[2], v1[3]);
                    *(u32x2*)(rowp + bj * HALF) = w; } }
    }
};

typedef int i32x4 __attribute__((ext_vector_type(4)));
typedef int i32x8 __attribute__((ext_vector_type(8)));
template <class Epi, class Sched, bool ALIGN_EPI, bool SP2, bool FP8 = false>
__device__ __forceinline__ void gemm_phase(LAS unsigned char* lds, const int K, const Sched& S, const Epi& E) {
    const int tid = threadIdx.x, wid = __builtin_amdgcn_readfirstlane(tid >> 6), lane = tid & 63, wr = wid >> 2, wc = wid & 3, fr = lane & 15, fq = lane >> 4;
    const int nt = K / BK;
    int Rr[2], Cc[2]; unsigned voffB[2];
#pragma unroll
    for (int i = 0; i < 2; ++i) { int R, C; stage_rc(tid * 16 + i * 8192, R, C); const int Rb = Epi::PERM ? ((R & ~31) + perm32(R & 31)) : R;
        Rr[i] = R; Cc[i] = C; voffB[i] = (unsigned)(Rb * K + C) * 2u; }
    const size_t kstep = (size_t)(BK * 2);
    const size_t hstep = (size_t)HALF * K * 2;
    const unsigned ldsw = (unsigned)wid * 1024u;
    const int aoff = lds_byte(wr * 64 + fr, fq * 8), boff = lds_byte(wc * 32 + fr, fq * 8);
#define PG8_SA(b, h) (((b) * 2 + (h)) * HTB)
#define PG8_SB(b, h) ((4 + (b) * 2 + (h)) * HTB)
#define PG8_STAGE(bufoff, gbase, voff) do { _Pragma("unroll") for (int _i = 0; _i < 2; ++_i) \
        __builtin_amdgcn_global_load_lds((const unsigned*)((const char*)(gbase) + (voff)[_i]), (LAS unsigned*)(lds + (bufoff) + ldsw + _i * 8192), 16, 0, 0); } while (0)
#define PG8_LD8(p) __builtin_shufflevector(*(const LAS i32x4*)(p), *(const LAS i32x4*)((p) + 1024), 0, 1, 2, 3, 4, 5, 6, 7)
#define PG8_LDA(dst, b, h) do { _Pragma("unroll") for (int m = 0; m < 4; ++m) dst[m] = PG8_LD8(lds + PG8_SA(b, h) + aoff + m * 2048); } while (0)
#define PG8_LDB(dst, b, h) do { _Pragma("unroll") for (int n = 0; n < 2; ++n) dst[n] = PG8_LD8(lds + PG8_SB(b, h) + boff + n * 2048); } while (0)
#define PG8_LO(x) __builtin_bit_cast(bf16x8, __builtin_shufflevector(x, x, 0, 1, 2, 3))
#define PG8_HI(x) __builtin_bit_cast(bf16x8, __builtin_shufflevector(x, x, 4, 5, 6, 7))
#define PG8_MMA(ai, bj, At, Bt) do { if (FP8 && (ai) == 1 && cur.nvalid <= HALF) break;     \
        __builtin_amdgcn_s_setprio(1); _Pragma("unroll") for (int m = 0; m < 4; ++m) _Pragma("unroll") for (int n = 0; n < 2; ++n) { \
        if constexpr (FP8) asm volatile("v_mfma_f32_16x16x128_f8f6f4 %0, %1, %2, %0" : "+v"(acc[ai][bj][m][n]) : "v"(Bt[n]), "v"(At[m])); \
        else { acc[ai][bj][m][n] = __builtin_amdgcn_mfma_f32_16x16x32_bf16(PG8_LO(Bt[n]), PG8_LO(At[m]), acc[ai][bj][m][n], 0, 0, 0); \
               acc[ai][bj][m][n] = __builtin_amdgcn_mfma_f32_16x16x32_bf16(PG8_HI(Bt[n]), PG8_HI(At[m]), acc[ai][bj][m][n], 0, 0, 0); } } \
        __builtin_amdgcn_s_setprio(0); } while (0)
#define PG8_WAIT_V(n) asm volatile("s_waitcnt vmcnt(" #n ")" ::: "memory")
#define PG8_WAIT_L(n) asm volatile("s_waitcnt lgkmcnt(" #n ")" ::: "memory")
#define PG8_BAR __builtin_amdgcn_s_barrier()
#define PG8_SCHED __builtin_amdgcn_sched_barrier(0)
    Unit cur, nxt; int ui = 0;
    if (!S.next(0, cur)) return;
    f32x4 acc[2][2][4][2];
#pragma unroll
    for (int a = 0; a < 2; ++a)
#pragma unroll
        for (int b = 0; b < 2; ++b)
#pragma unroll
            for (int m = 0; m < 4; ++m)
#pragma unroll
                for (int n = 0; n < 2; ++n) acc[a][b][m][n] = (f32x4){0.f, 0.f, 0.f, 0.f};
    i32x8 At[4], B0[2], B1[2];
    const char* gA = S.a_base();
    unsigned cvA[2][2], nvA[2][2];
    S.a_offsets(cur, Rr, Cc, cvA);
    const char* cB = S.b_ptr(cur);
    if constexpr (SP2) {
        PG8_STAGE(PG8_SB(0, 0), cB, voffB); PG8_STAGE(PG8_SB(0, 1), cB + hstep, voffB); PG8_STAGE(PG8_SA(0, 0), gA, cvA[0]); PG8_STAGE(PG8_SA(0, 1), gA, cvA[1]);
        if (wr == 1) PG8_BAR;
        PG8_WAIT_V(2); PG8_BAR;
        PG8_STAGE(PG8_SB(1, 0), cB + kstep, voffB); PG8_STAGE(PG8_SA(1, 0), gA + kstep, cvA[0]); PG8_STAGE(PG8_SB(1, 1), cB + hstep + kstep, voffB);
        PG8_WAIT_V(6); PG8_BAR;
    } else {
        PG8_STAGE(PG8_SB(0, 0), cB, voffB); PG8_STAGE(PG8_SA(0, 0), gA, cvA[0]); PG8_STAGE(PG8_SB(0, 1), cB + hstep, voffB); PG8_STAGE(PG8_SA(0, 1), gA, cvA[1]);
        if (wr == 1) PG8_BAR;
        PG8_WAIT_V(4); PG8_BAR;
        PG8_STAGE(PG8_SB(1, 0), cB + kstep, voffB); PG8_STAGE(PG8_SA(1, 0), gA + kstep, cvA[0]); PG8_STAGE(PG8_SB(1, 1), cB + hstep + kstep, voffB);
        PG8_WAIT_V(6); PG8_BAR;
    }
    for (;;) {
        const bool has_next = S.next(ui + 1, nxt);
        const char* nB = cB;
        if (has_next) { S.a_offsets(nxt, Rr, Cc, nvA); nB = S.b_ptr(nxt); }
        else {
#pragma unroll
            for (int h = 0; h < 2; ++h)
#pragma unroll
                for (int i = 0; i < 2; ++i) nvA[h][i] = cvA[h][i];
        }
        for (int t = 0; t < nt; t += 2) {
            const bool last = (t == nt - 2);
            const char* a1 = gA + (size_t)(t + 1) * kstep;
            const char* a2 = last ? gA : gA + (size_t)(t + 2) * kstep; const char* b2 = last ? nB : cB + (size_t)(t + 2) * kstep;
            const char* a3 = a2 + kstep; const char* b3 = b2 + kstep;
            unsigned o2[2][2];
#pragma unroll
            for (int h = 0; h < 2; ++h)
#pragma unroll
                for (int i = 0; i < 2; ++i) o2[h][i] = last ? nvA[h][i] : cvA[h][i];
            if constexpr (SP2) {
            PG8_LDB(B0, 0, 0); PG8_LDB(B1, 0, 1); PG8_SCHED; PG8_LDA(At, 0, 0); PG8_STAGE(PG8_SA(1, 1), a1, cvA[1]);
            PG8_WAIT_V(8); PG8_WAIT_L(0); PG8_BAR; PG8_MMA(0, 0, At, B0); PG8_MMA(0, 1, At, B1); PG8_BAR; PG8_SCHED;
            PG8_LDA(At, 0, 1); PG8_STAGE(PG8_SB(0, 0), b2, voffB); PG8_STAGE(PG8_SB(0, 1), b2 + hstep, voffB); PG8_STAGE(PG8_SA(0, 0), a2, o2[0]);
            PG8_WAIT_V(8); PG8_WAIT_L(0); PG8_BAR; PG8_MMA(1, 0, At, B0); PG8_MMA(1, 1, At, B1); PG8_BAR; PG8_SCHED;
            PG8_LDB(B0, 1, 0); PG8_LDB(B1, 1, 1); PG8_SCHED; PG8_LDA(At, 1, 0); PG8_STAGE(PG8_SA(0, 1), a2, o2[1]);
            PG8_WAIT_V(8); PG8_WAIT_L(0); PG8_BAR; PG8_MMA(0, 0, At, B0); PG8_MMA(0, 1, At, B1); PG8_BAR; PG8_SCHED;
            PG8_LDA(At, 1, 1); PG8_STAGE(PG8_SB(1, 0), b3, voffB); PG8_STAGE(PG8_SB(1, 1), b3 + hstep, voffB); PG8_STAGE(PG8_SA(1, 0), a3, o2[0]);
            PG8_WAIT_V(8); PG8_WAIT_L(0); PG8_BAR; PG8_MMA(1, 0, At, B0); PG8_MMA(1, 1, At, B1); PG8_BAR; PG8_SCHED;
            } else {
            PG8_LDB(B0, 0, 0); PG8_SCHED; PG8_LDA(At, 0, 0); PG8_STAGE(PG8_SA(1, 1), a1, cvA[1]);
            PG8_WAIT_L(8); PG8_BAR; PG8_WAIT_L(0); PG8_MMA(0, 0, At, B0); PG8_BAR; PG8_SCHED;
            PG8_LDB(B1, 0, 1); PG8_STAGE(PG8_SB(0, 0), b2, voffB);
            PG8_BAR; PG8_WAIT_L(0); PG8_MMA(0, 1, At, B1); PG8_BAR;
            PG8_LDA(At, 0, 1); PG8_STAGE(PG8_SA(0, 0), a2, o2[0]);
            PG8_BAR; PG8_WAIT_L(0); PG8_MMA(1, 0, At, B0); PG8_BAR; PG8_SCHED;
            PG8_STAGE(PG8_SB(0, 1), b2 + hstep, voffB);
            PG8_WAIT_V(6); PG8_BAR; PG8_MMA(1, 1, At, B1); PG8_BAR;
            PG8_LDB(B0, 1, 0); PG8_SCHED; PG8_LDA(At, 1, 0); PG8_STAGE(PG8_SA(0, 1), a2, o2[1]);
            PG8_WAIT_L(8); PG8_BAR; PG8_WAIT_L(0); PG8_MMA(0, 0, At, B0); PG8_BAR; PG8_SCHED;
            PG8_LDB(B1, 1, 1); PG8_STAGE(PG8_SB(1, 0), b3, voffB);
            PG8_BAR; PG8_WAIT_L(0); PG8_MMA(0, 1, At, B1); PG8_BAR;
            PG8_LDA(At, 1, 1); PG8_STAGE(PG8_SA(1, 0), a3, o2[0]);
            PG8_BAR; PG8_WAIT_L(0); PG8_MMA(1, 0, At, B0); PG8_BAR; PG8_SCHED;
            PG8_STAGE(PG8_SB(1, 1), b3 + hstep, voffB);
            PG8_WAIT_V(6); PG8_BAR; PG8_MMA(1, 1, At, B1); PG8_BAR;
            }
        }
        if constexpr (ALIGN_EPI) { if (wr == 0) PG8_BAR; }
        if constexpr (FP8) asm volatile("s_nop 15\n\ts_nop 15" ::: "memory");
        E(acc, cur, wr, wc, fr, fq);
        if (!has_next) break;
#pragma unroll
        for (int a = 0; a < 2; ++a)
#pragma unroll
            for (int b = 0; b < 2; ++b)
#pragma unroll
                for (int m = 0; m < 4; ++m)
#pragma unroll
                    for (int n = 0; n < 2; ++n) acc[a][b][m][n] = (f32x4){0.f, 0.f, 0.f, 0.f};
        cur = nxt; cB = nB; ++ui;
#pragma unroll
        for (int h = 0; h < 2; ++h)
#pragma unroll
            for (int i = 0; i < 2; ++i) cvA[h][i] = nvA[h][i];
        if constexpr (ALIGN_EPI) { if (wr == 1) PG8_BAR; }
    }
    PG8_WAIT_V(0);
    if constexpr (!ALIGN_EPI) { if (wr == 0) PG8_BAR; }
    PG8_BAR;
#undef PG8_SA
#undef PG8_SB
#undef PG8_STAGE
#undef PG8_LDA
#undef PG8_LDB
#undef PG8_MMA
#undef PG8_LO
#undef PG8_HI
#undef PG8_LD8
#undef PG8_WAIT_V
#undef PG8_WAIT_L
#undef PG8_BAR
#undef PG8_SCHED
}
}

#define XB_TMO      128
#define XB_XCNT(j)  (256  + 64 * (j))
#define XB_XSUB(j)  (1280 + 64 * (j))
#define XB_XGEN(j)  (2304 + 64 * (j))
#define XB_TOP      3328
#define XB_TOPGEN   3392
#define XCD_BAR_WORDS 3456
#define XB_SPIN_CAP (1u << 18)
__device__ __forceinline__ unsigned xb_ld(unsigned* p)              { return __hip_atomic_load(p, __ATOMIC_RELAXED, __HIP_MEMORY_SCOPE_AGENT); }
__device__ __forceinline__ unsigned xb_add(unsigned* p, unsigned v) { return __hip_atomic_fetch_add(p, v, __ATOMIC_RELAXED, __HIP_MEMORY_SCOPE_AGENT); }
__device__ __forceinline__ unsigned xb_xcc_id() { return (unsigned)__builtin_amdgcn_s_getreg((3 << 11) | 20) & 0xFu; }
#define XB_SPIN(cond, bar) do { unsigned _sp = 0; while (cond) { __builtin_amdgcn_s_sleep(1); \
    if ((++_sp & 255u) == 0u) { if (xb_ld(&(bar)[XB_TMO])) break; if (_sp > XB_SPIN_CAP) { atomicAdd(&(bar)[XB_TMO], 1u); break; } } } } while (0)
struct XcdBarrier { unsigned* bar; unsigned x; volatile LAS unsigned* st; };
__device__ __forceinline__ XcdBarrier xcd_barrier_post(unsigned* bar, volatile LAS unsigned* st) {
    XcdBarrier b; b.bar = bar; b.x = xb_xcc_id(); b.st = st;
    if (threadIdx.x == 0) (void)xb_add(&bar[XB_XCNT(b.x)], 1u);
    return b;
}
__device__ __forceinline__ void xcd_barrier_complete(unsigned* bar, unsigned x, unsigned& nloc, unsigned& nx) {
    const unsigned G = gridDim.x * gridDim.y * gridDim.z;
    unsigned sum, cnt, mine, sp = 0u;
    for (;;) {
        sum = 0u; cnt = 0u; mine = 0u;
#pragma unroll
        for (unsigned j = 0; j < 16; ++j) { const unsigned c = xb_ld(&bar[XB_XCNT(j)]); sum += c; cnt += (c > 0u) ? 1u : 0u; mine = (j == x) ? c : mine; }
        if (sum == G) break;
        __builtin_amdgcn_s_sleep(1);
        if ((++sp & 255u) == 0u) { if (xb_ld(&bar[XB_TMO])) break; if (sp > XB_SPIN_CAP) { atomicAdd(&bar[XB_TMO], 1u); break; } }
    }
    nloc = mine > 0u ? mine : 1u; nx = cnt > 0u ? cnt : 1u;
}
__device__ __forceinline__ void xcd_barrier(const XcdBarrier& b) {
    asm volatile("s_waitcnt vmcnt(0)" ::: "memory");
    __syncthreads();
    if (threadIdx.x == 0) {
        unsigned* bar = b.bar;
        __builtin_amdgcn_s_waitcnt(0);
        unsigned nloc = b.st[0], nx = b.st[1];
        if (nloc == 0u) { xcd_barrier_complete(bar, b.x, nloc, nx); b.st[0] = nloc; b.st[1] = nx; }
        const unsigned old = xb_add(&bar[XB_XSUB(b.x)], 1u);
        const unsigned gen = old / nloc;
        if (old + 1u == (gen + 1u) * nloc) {
            __builtin_amdgcn_fence(__ATOMIC_RELEASE, "agent");
            asm volatile("s_waitcnt vmcnt(0)" ::: "memory");
            const unsigned og = xb_add(&bar[XB_TOP], 1u);
            const unsigned tg = og / nx;
            if (og + 1u == (tg + 1u) * nx) xb_add(&bar[XB_TOPGEN], 1u);
            else XB_SPIN(xb_ld(&bar[XB_TOPGEN]) == tg, bar);
            __builtin_amdgcn_fence(__ATOMIC_ACQUIRE, "agent");
            xb_add(&bar[XB_XGEN(b.x)], 1u);
            asm volatile("s_waitcnt vmcnt(0)" ::: "memory");
        } else {
            XB_SPIN(xb_ld(&bar[XB_XGEN(b.x)]) == gen, bar);
            __builtin_amdgcn_fence(__ATOMIC_ACQUIRE, "agent");
            asm volatile("s_waitcnt vmcnt(0)" ::: "memory");
        }
    }
    __syncthreads();
}

struct Args { const float* in[20]; float* out; unsigned char* ws; int ph_lo, ph_hi, dry, sub; };
enum { I_X = 0, I_G1, I_WIN, I_CONVW, I_CONVB, I_LNG, I_LNB, I_QG, I_KG, I_LAMQK, I_SUBG, I_RELB, I_WOUT, I_G2, I_RW, I_RB, I_WGU, I_BGU, I_WD, I_BD };

struct Frame {
    LAS unsigned char* lds;
    int tid, lane, wave, vcu, G;
    const float* const* in;
    float* out; unsigned char* ws;
};

template <int MODE>
__device__ __forceinline__ void transpose_item64(const float* W, int K, int N, bf16* WT, int row_off, LAS float* scr, int item, int lane) {
    const int nblk = N / 64, kb = item / nblk, nb = item - kb * nblk, k0 = 64 * kb, n0 = 64 * nb;
    f32x4 v[16];
#pragma unroll
    for (int it = 0; it < 16; ++it) { const int kr = 4 * it + (lane >> 4); v[it] = *(const GAS f32x4*)(W + (size_t)(k0 + kr) * N + n0 + 4 * (lane & 15)); }
#pragma unroll
    for (int it = 0; it < 16; ++it) { const int kr = 4 * it + (lane >> 4); const int col = (4 * (lane & 15) + 8 * (kr >> 3)) & 63; *(LAS f32x4*)(scr + kr * 64 + col) = v[it]; }
    LDS_WAIT(); asm volatile("" ::: "memory");
    const int kc = lane & 7;
#pragma unroll
    for (int jt = 0; jt < 8; ++jt) { const int n = 8 * jt + (lane >> 3); const int col = (n + 8 * kc) & 63; const LAS float* s = scr + (8 * kc) * 64 + col;
        u32x4 o; o.x = pk2(s[0], s[64]); o.y = pk2(s[128], s[192]); o.z = pk2(s[256], s[320]); o.w = pk2(s[384], s[448]);
        int row;
        if (MODE == 0) row = row_off + n0 + n;
        else {
            const int c = n0 + n;
            if (c < 1024) { const int j = c & 511, isg = c >> 9; row = 256 * (j >> 7) + (j & 127) + 128 * isg; }
            else if (c < 2048) { const int cc = c - 1024, t = cc >> 8, w = cc & 255, wc = w >> 6, r = w & 63; row = 1024 + 256 * t + 128 * (r >> 5) + 32 * wc + (r & 31); }
            else row = c;
        }
        *(GAS u32x4*)(WT + (size_t)row * K + k0 + 8 * kc) = o; }
    LDS_WAIT(); asm volatile("" ::: "memory");
}
constexpr int CVT_GU_ITEMS = NE * 512, CVT_ITEMS = NE * 512 + NE * 256;
constexpr int CVT_A = 0, CVT_B = 72, CVT_3 = 60;
static_assert(128 * CVT_A + 128 * CVT_B + 256 * CVT_3 == CVT_ITEMS, "conversion schedule covers every item once");
struct CvtItem { const float* src; unsigned char* dst; int N, mode, n0; };
__device__ __forceinline__ CvtItem cvt_decode(const Frame& F, int id) {
    CvtItem c;
    if (id < CVT_GU_ITEMS) { const int e = id >> 9, q = id & 511, kb = q >> 6, nb = q & 63; c.N = 2 * DFF; c.mode = 1; c.n0 = 32 * nb;
        c.src = F.in[I_WGU] + (size_t)e * DM * 2 * DFF + (size_t)(128 * kb) * (2 * DFF) + 32 * nb; c.dst = F.ws + WS_WGU + (size_t)e * 2 * DFF * DM + 128 * kb; }
    else { const int r = id - CVT_GU_ITEMS, e = r >> 8, q = r & 255, kb = q >> 5, nb = q & 31; c.N = DM; c.mode = 0; c.n0 = 32 * nb;
        c.src = F.in[I_WD] + (size_t)e * DFF * DM + (size_t)(128 * kb) * DM + 32 * nb; c.dst = F.ws + WS_WD + (size_t)e * DM * DFF + 128 * kb; }
    return c;
}
__device__ __forceinline__ void cvt_load(f32x4 (&v)[16], const CvtItem& c, int lane) {
#pragma unroll
    for (int it = 0; it < 16; ++it) { const int kr = 8 * it + (lane >> 3); v[it] = __builtin_nontemporal_load((const GAS f32x4*)(c.src + (size_t)kr * c.N + 4 * (lane & 7))); }
}
__device__ __forceinline__ void cvt_finish(const f32x4 (&v)[16], const CvtItem& c, LAS float* scr, int lane) {
#pragma unroll
    for (int it = 0; it < 16; ++it) { const int kr = 8 * it + (lane >> 3); const int col = (4 * (lane & 7) + 4 * ((kr >> 4) & 7)) & 31; *(LAS f32x4*)(scr + kr * 32 + col) = v[it]; }
    LDS_WAIT(); asm volatile("" ::: "memory");
    const int kc = lane & 7;
#pragma unroll
    for (int jt = 0; jt < 4; ++jt) { const int n = 8 * jt + (lane >> 3); const int col = (n + 4 * kc) & 31; const LAS float* s = scr + (16 * kc) * 32 + col;
        u32x4 o;
#pragma unroll
        for (int q = 0; q < 4; ++q) o[q] = pk4_fp8(s[(4 * q) * 32] * W8_SCALE, s[(4 * q + 1) * 32] * W8_SCALE, s[(4 * q + 2) * 32] * W8_SCALE, s[(4 * q + 3) * 32] * W8_SCALE);
        const int cc = c.n0 + n; int row = cc;
        if (c.mode) { const int j = cc >> 1; row = (j >> 7) * 256 + (j & 127) + 128 * (cc & 1); }
        __builtin_nontemporal_store(o, (GAS u32x4*)(c.dst + (size_t)row * DM + 16 * kc)); }
    LDS_WAIT(); asm volatile("" ::: "memory");
}
__device__ __forceinline__ void convert_items(Frame& F, int first, int count) {
    LAS float* scr = (LAS float*)(F.lds + F.wave * 16384);
    const int end = first + count; int it = first + F.wave;
    f32x4 va[16], vb[16]; CvtItem ca, cb;
    if (it < end) { ca = cvt_decode(F, it); cvt_load(va, ca, F.lane); }
    for (; it < end; it += 16) {
        if (it + 8 < end) { cb = cvt_decode(F, it + 8); cvt_load(vb, cb, F.lane); }
        cvt_finish(va, ca, scr, F.lane);
        if (it + 16 < end) { ca = cvt_decode(F, it + 16); cvt_load(va, ca, F.lane); }
        if (it + 8 < end) cvt_finish(vb, cb, scr, F.lane);
    }
}
__device__ __forceinline__ void rms_row_to_bf16(int lane, const float* xrow, const float* g, bf16* orow) {
    const GAS f32x4* xr = (const GAS f32x4*)xrow + lane;
    f32x4 v[4]; float s = 0.f;
#pragma unroll
    for (int j = 0; j < 4; ++j) { v[j] = xr[64 * j]; s += (v[j].x * v[j].x + v[j].y * v[j].y) + (v[j].z * v[j].z + v[j].w * v[j].w); }
    const float rstd = 1.0f / sqrtf(wave_sum(s) * (1.f / DM) + EPS);
    GAS u32x2* o8 = (GAS u32x2*)orow + lane;
#pragma unroll
    for (int j = 0; j < 4; ++j) { const f32x4 gg = *((const GAS f32x4*)g + lane + 64 * j); u32x2 w; w.x = pk2(v[j].x * rstd * gg.x, v[j].y * rstd * gg.y); w.y = pk2(v[j].z * rstd * gg.z, v[j].w * rstd * gg.w); o8[64 * j] = w; }
}

__device__ __forceinline__ void p0_prologue(Frame& F, bool cvt_all) {
    LAS float* scr = (LAS float*)(F.lds + F.wave * 16384);
    const int gw = F.vcu * NWAVES + F.wave, NGW = F.G * NWAVES;
    constexpr int I_IN = (DM / 64) * (DIN / 64), I_OUT = (DM / 64) * (DM / 64);
    constexpr int NITEMS = I_IN + I_OUT;
    bf16* Win_t = (bf16*)(F.ws + WS_WIN); bf16* Wout_t = (bf16*)(F.ws + WS_WOUT);
    for (int it = gw; it < NITEMS; it += NGW) {
        int r = it;
        if (r < I_IN) { transpose_item64<2>(F.in[I_WIN], DM, DIN, Win_t, 0, scr, r, F.lane); continue; } r -= I_IN;
        transpose_item64<0>(F.in[I_WOUT], DM, DM, Wout_t, 0, scr, r, F.lane);
    }
    if (cvt_all) { const int per = (CVT_ITEMS + F.G - 1) / F.G, f0 = F.vcu * per; int n = CVT_ITEMS - f0; n = n < per ? n : per; if (n > 0) convert_items(F, f0, n); }
    {
        bf16* wrt = (bf16*)(F.ws + WS_WRT);
        for (int i = F.vcu * (NWAVES * 64) + F.tid; i < DM * NE; i += F.G * NWAVES * 64) {
            const int k = i >> 5, e = i & 31; const float w = F.in[I_RW][i] * F.in[I_G2][k];
            const unsigned hb = f2bf(w); const float hf = __builtin_bit_cast(float, hb << 16);
            wrt[e * DM + k] = (bf16)hb; wrt[NE * DM + e * DM + k] = (bf16)f2bf(w - hf);
        }
    }
    bf16* XN = (bf16*)(F.ws + WS_XN);
    for (int m = gw; m < NTOK; m += NGW) rms_row_to_bf16(F.lane, F.in[I_X] + (size_t)m * DM, F.in[I_G1], XN + (size_t)m * DM);
}

__device__ __forceinline__ void p3_conv(Frame& F) {
    const bf16* U = (const bf16*)(F.ws + WS_U); bf16* mixed = (bf16*)(F.ws + WS_MIX);
    LAS bf16* ubuf = (LAS bf16*)F.lds;
    LAS float* ybuf = (LAS float*)(F.lds + 98304);
    LAS float* stt = ybuf + 16 * DCONV;
    const int c = F.tid;
    f32x2 cwA[15], cwB[15];
#pragma unroll
    for (int j = 0; j < 15; ++j) { const float w0 = F.in[I_CONVW][(2 * j) * DCONV + c], w1 = F.in[I_CONVW][(2 * j + 1) * DCONV + c], w2 = F.in[I_CONVW][(2 * j + 2) * DCONV + c];
        cwA[j] = (f32x2){w0, w1}; cwB[j] = (f32x2){w1, w2}; }
    const float cw0 = F.in[I_CONVW][c], cw30 = F.in[I_CONVW][30 * DCONV + c];
    const float cb = F.in[I_CONVB][c], lg = F.in[I_LNG][c], lb = F.in[I_LNB][c];
    for (int tile = F.vcu; tile < NTOK / 64; tile += F.G) {
        const int b = tile / (SEQ / 64), t0 = (tile % (SEQ / 64)) * 64;
        __syncthreads();
        {
            u32x4 uv[12];
#pragma unroll
            for (int k = 0; k < 12; ++k) {
                const int it = F.tid + k * (NWAVES * 64); const int row = it >> 6, ch = (it & 63) * 8; int tt = t0 - 30 + row; tt = tt < 0 ? 0 : tt;
                if (it < 94 * 64) uv[k] = *(const GAS u32x4*)(U + (size_t)(b * SEQ + tt) * DCONV + ch);
            }
#pragma unroll
            for (int k = 0; k < 12; ++k) {
                const int it = F.tid + k * (NWAVES * 64); const int row = it >> 6, ch = (it & 63) * 8; const bool live = (t0 - 30 + row) >= 0;
                if (it < 94 * 64) *(LAS u32x4*)(ubuf + row * DCONV + ch) = live ? uv[k] : (u32x4){0u, 0u, 0u, 0u};
            }
        }
        LDS_WAIT(); __syncthreads();
        f32x2 win2[23];
#pragma unroll
        for (int j = 0; j < 15; ++j) win2[j] = (f32x2){bf2f(ubuf[(2 * j) * DCONV + c]), bf2f(ubuf[(2 * j + 1) * DCONV + c])};
        bf16* orow = mixed + (size_t)(b * SEQ + t0) * DM + c;
#pragma unroll 1
        for (int o16 = 0; o16 < 4; ++o16) {
            float y[16];
#pragma unroll
            for (int q = 0; q < 8; ++q) win2[15 + q] = (f32x2){bf2f(ubuf[(30 + o16 * 16 + 2 * q) * DCONV + c]), bf2f(ubuf[(31 + o16 * 16 + 2 * q) * DCONV + c])};
#pragma unroll
            for (int q = 0; q < 16; ++q) {
                f32x2 a2 = (f32x2){cb, 0.f};
                if ((q & 1) == 0) {
#pragma unroll
                    for (int j = 0; j < 15; ++j) a2 += cwA[j] * win2[(q >> 1) + j];
                    y[q] = (a2.x + a2.y) + cw30 * win2[(q >> 1) + 15].x;
                } else {
#pragma unroll
                    for (int j = 0; j < 15; ++j) a2 += cwB[j] * win2[((q + 1) >> 1) + j];
                    y[q] = (a2.x + a2.y) + cw0 * win2[q >> 1].y;
                }
            }
#pragma unroll
            for (int q = 0; q < 16; ++q) ybuf[q * DCONV + c] = y[q];
            LDS_WAIT(); __syncthreads();
#pragma unroll
            for (int t2 = 0; t2 < 2; ++t2) {
                const int tk = F.wave * 2 + t2;
                const f32x4 v0 = *(const LAS f32x4*)(ybuf + tk * DCONV + F.lane * 8), v1 = *(const LAS f32x4*)(ybuf + tk * DCONV + F.lane * 8 + 4);
                const float sm = wave_sum((v0.x + v0.y) + (v0.z + v0.w) + (v1.x + v1.y) + (v1.z + v1.w));
                const float sq = wave_sum((v0.x * v0.x + v0.y * v0.y) + (v0.z * v0.z + v0.w * v0.w) + (v1.x * v1.x + v1.y * v1.y) + (v1.z * v1.z + v1.w * v1.w));
                const float mean = sm * (1.0f / DCONV), var = fmaxf(sq * (1.0f / DCONV) - mean * mean, 0.f);
                if (F.lane == 0) { stt[tk * 2] = mean; stt[tk * 2 + 1] = 1.0f / sqrtf(var + EPS); }
            }
            LDS_WAIT(); __syncthreads();
            f32x4 sv[8];
#pragma unroll
            for (int i = 0; i < 8; ++i) sv[i] = *(const LAS f32x4*)(stt + 4 * i);
#pragma unroll
            for (int q = 0; q < 16; ++q) {
                const float mean = sv[q >> 1][(q & 1) * 2], rstd = sv[q >> 1][(q & 1) * 2 + 1];
                const float z = (y[q] - mean) * rstd * lg + lb;
                const float o = z * __builtin_amdgcn_rcpf(1.0f + __builtin_amdgcn_exp2f(-LOG2E * z));
                orow[(size_t)(o16 * 16 + q) * DM] = (bf16)f2bf(o);
            }
#pragma unroll
            for (int j = 0; j < 15; ++j) win2[j] = win2[j + 8];
        }
    }
}

__device__ __forceinline__ int t5_bucket(int rel) {
    const int n = rel < 0 ? -rel : rel; int bkt;
    if (n < 8) bkt = n; else { const int k = 31 - __builtin_clz((unsigned)(n * n) >> 6); bkt = 8 + k; if (bkt > 15) bkt = 15; }
    return bkt + (rel > 0 ? 16 : 0);
}
constexpr int AT_STAGE = 32768;
__device__ __forceinline__ int swap23(int r) { return (r & ~12) | ((r & 4) << 1) | ((r & 8) >> 1); }

__device__ __forceinline__ void attn_unit2(Frame& F, int b, int h, int qb, float lam, float bsh) {
    const bf16* QK = (const bf16*)(F.ws + WS_QK); const bf16* Vt = (const bf16*)(F.ws + WS_VT); bf16* mixed = (bf16*)(F.ws + WS_MIX);
    const int lane = F.lane, wid = F.wave, m = wid >> 2, grp = (wid ^ (wid >> 2)) & 1, rg = 2 * grp + ((wid >> 1) & 1), r32 = lane & 31, hi = lane >> 5;
    const int qrow = qb * 128 + 32 * rg + r32, cq = 2 * qb + (rg >> 1), ntile = 2 * qb + 2;
    LAS unsigned char* lds = F.lds;
    const LAS float* lut = (const LAS float*)(F.lds + LDSX_OFF);
    bf16x8 qf[4];
    { const bf16* qp = QK + (size_t)(b * SEQ + qrow) * DM + h * 128 + m * 64 + hi * 8;
#pragma unroll
      for (int d0 = 0; d0 < 4; ++d0) qf[d0] = *(const GAS bf16x8*)(qp + d0 * 16); }
    const int rho = 8 * wid + (lane >> 3), cpos = lane & 7;
    const bf16* ksrc = QK + (size_t)(b * SEQ + swap23(rho)) * DM + 512 + h * 128 + ((cpos ^ ((rho >> 1) & 7)) << 3);
    const bf16* vsrc = Vt + (size_t)((b * NH + h) * DV + rho) * SEQ + ((cpos ^ ((rho >> 1) & 7)) << 3);
    const unsigned ldsw = (unsigned)wid * 1024u;
#define AT_DMA(j, st) do { LAS unsigned char* sb_ = lds + (st) * AT_STAGE + ldsw; \
        __builtin_amdgcn_global_load_lds((const unsigned*)(ksrc + (size_t)(j) * 64 * DM), (LAS unsigned*)(sb_), 16, 0, 0); \
        __builtin_amdgcn_global_load_lds((const unsigned*)(ksrc + (size_t)(j) * 64 * DM + 64), (LAS unsigned*)(sb_ + 8192), 16, 0, 0); \
        __builtin_amdgcn_global_load_lds((const unsigned*)(vsrc + (j) * 64), (LAS unsigned*)(sb_ + 16384), 16, 0, 0); \
        __builtin_amdgcn_global_load_lds((const unsigned*)(vsrc + (size_t)64 * SEQ + (j) * 64), (LAS unsigned*)(sb_ + 24576), 16, 0, 0); } while (0)
    const int swz = (r32 >> 1) & 7;
    unsigned foff[4];
#pragma unroll
    for (int s = 0; s < 4; ++s) foff[s] = (unsigned)(r32 * 128 + (((2 * s + hi) ^ swz) << 4));
    f32x16 o[4];
#pragma unroll
    for (int i = 0; i < 4; ++i)
#pragma unroll
        for (int r = 0; r < 16; ++r) o[i][r] = 0.f;
    float lrun = 0.f, lrun2 = 0.f;
    const float c15 = lut[0];
    f32x16 c15v;
#pragma unroll
    for (int r = 0; r < 16; ++r) c15v[r] = c15;
    asm volatile("" : "+v"(c15v));
    bf16x8 pfA[4];
    f32x16 sa[2];
#define AT_KLD(j) do { const LAS unsigned char* kb = lds + ((j) & 3) * AT_STAGE + m * 8192; \
        _Pragma("unroll") for (int hh = 0; hh < 2; ++hh) _Pragma("unroll") for (int d0 = 0; d0 < 4; ++d0) kfr[hh * 4 + d0] = *(const LAS bf16x8*)(kb + hh * 4096 + foff[d0]); } while (0)
#define AT_QK(j) do { \
        if (cq - (j) >= 3) {   \
            _Pragma("unroll") for (int hh = 0; hh < 2; ++hh) sa[hh] = __builtin_amdgcn_mfma_f32_32x32x16_bf16(kfr[hh * 4], qf[0], c15v, 0, 0, 0); \
        } else { const int bi = 64 * ((j) - cq) + 8 * hi - 32 * (rg & 1) - r32 + 191; \
            _Pragma("unroll") for (int hh = 0; hh < 2; ++hh) _Pragma("unroll") for (int r = 0; r < 16; ++r) sa[hh][r] = lut[bi + 32 * hh + 16 * (r >> 3) + (r & 7)]; \
            _Pragma("unroll") for (int hh = 0; hh < 2; ++hh) sa[hh] = __builtin_amdgcn_mfma_f32_32x32x16_bf16(kfr[hh * 4], qf[0], sa[hh], 0, 0, 0); } \
        _Pragma("unroll") for (int d0 = 1; d0 < 4; ++d0) _Pragma("unroll") for (int hh = 0; hh < 2; ++hh) sa[hh] = __builtin_amdgcn_mfma_f32_32x32x16_bf16(kfr[hh * 4 + d0], qf[d0], sa[hh], 0, 0, 0); } while (0)
#define AT_SM1(PW, s_) do { u32x4 pw; _Pragma("unroll") for (int i = 0; i < 4; ++i) { \
            const float p0 = __builtin_amdgcn_exp2f(sa[(s_) >> 1][8 * ((s_) & 1) + 2 * i]), p1 = __builtin_amdgcn_exp2f(sa[(s_) >> 1][8 * ((s_) & 1) + 2 * i + 1]); \
            lrun += p0; lrun2 += p1; pw[i] = pk2c(p0, p1); } PW[s_] = __builtin_bit_cast(bf16x8, pw); } while (0)
#define AT_SM(PW) do { AT_SM1(PW, 0); AT_SM1(PW, 1); AT_SM1(PW, 2); AT_SM1(PW, 3); } while (0)
#define AT_PV1(j, PR, s_) do { const LAS unsigned char* vb = lds + ((j) & 3) * AT_STAGE + 16384; \
        _Pragma("unroll") for (int db = 0; db < 4; ++db) { const bf16x8 vf = *(const LAS bf16x8*)(vb + db * 4096 + foff[s_]); o[db] = __builtin_amdgcn_mfma_f32_32x32x16_bf16(vf, PR[s_], o[db], 0, 0, 0); } } while (0)
#define AT_PV(j, PR) do { AT_PV1(j, PR, 0); AT_PV1(j, PR, 1); AT_PV1(j, PR, 2); AT_PV1(j, PR, 3); } while (0)
#define AT_SB __builtin_amdgcn_sched_barrier(0)
#define AT_PVSM(j, PR, PW) do { AT_SB; AT_PV1((j) - 1, PR, 0); AT_SM1(PW, 0); AT_SB; AT_PV1((j) - 1, PR, 1); AT_SM1(PW, 1); AT_SB; AT_PV1((j) - 1, PR, 2); AT_SM1(PW, 2); AT_SB; AT_PV1((j) - 1, PR, 3); AT_SM1(PW, 3); AT_SB; } while (0)
#define AT_TOP(j) do { asm volatile("s_waitcnt vmcnt(0)" ::: "memory"); __builtin_amdgcn_s_barrier();     \
        { const int jn = ((j) + 2 < ntile) ? (j) + 2 : 0; AT_DMA(jn, ((j) + 2) & 3); } } while (0)
    AT_DMA(0, 0); AT_DMA(1, 1);
    const int jend = grp == 0 ? ntile - 1 : ntile;
    bf16x8 kfr[8];
    AT_TOP(0); AT_KLD(0); AT_QK(0); if (1 < jend) AT_KLD(1); AT_SM(pfA);
    for (int j = 1; j < jend; ++j) { AT_TOP(j); AT_QK(j); if (j + 1 < jend) AT_KLD(j + 1); AT_PVSM(j, pfA, pfA); }
    if (grp == 0) AT_TOP(ntile - 1);
    AT_PV(jend - 1, pfA);
#undef AT_QK
#undef AT_KLD
#undef AT_SM1
#undef AT_SM
#undef AT_PV1
#undef AT_PV
#undef AT_PVSM
#undef AT_SB
#undef AT_TOP
#undef AT_DMA
    asm volatile("s_waitcnt vmcnt(0)" ::: "memory");
    __builtin_amdgcn_s_barrier();
    lrun += lrun2;
    const float ltot = lrun + __shfl_xor(lrun, 32);
    const float inv = 1.0f / ltot;
    LAS float* xb = (LAS float*)lds + rg * 4096;
    if (m == 1) {
        const float f = inv * lam;
#pragma unroll
        for (int db = 0; db < 4; ++db)
#pragma unroll
            for (int r = 0; r < 16; ++r) xb[(db * 16 + r) * 64 + lane] = o[db][r] * f;
    }
    LDS_WAIT(); __builtin_amdgcn_s_barrier(); asm volatile("" ::: "memory");
    if (m == 0) {
        float ss = 0.f;
#pragma unroll
        for (int db = 0; db < 4; ++db)
#pragma unroll
            for (int r = 0; r < 16; ++r) { const float d = o[db][r] * inv - xb[(db * 16 + r) * 64 + lane]; o[db][r] = d; ss += d * d; }
        ss += __shfl_xor(ss, 32);
        const float rstd = 0.8f / sqrtf(ss * (1.0f / DV) + EPS);
        bf16* orow = mixed + (size_t)(b * SEQ + qrow) * DM + DCONV + h * DV;
        const LAS float* sg = lut + 256;
#pragma unroll
        for (int db = 0; db < 4; ++db)
#pragma unroll
            for (int r4 = 0; r4 < 4; ++r4) {
                const int d = 32 * db + 8 * r4 + 4 * hi;
                const f32x4 g = *(const LAS f32x4*)(sg + d);
                u32x2 w; w.x = pk2(o[db][4 * r4] * rstd * g.x, o[db][4 * r4 + 1] * rstd * g.y); w.y = pk2(o[db][4 * r4 + 2] * rstd * g.z, o[db][4 * r4 + 3] * rstd * g.w);
                *(GAS u32x2*)(orow + d) = w;
            }
    }
    LDS_WAIT(); __builtin_amdgcn_s_barrier(); asm volatile("" ::: "memory");
}

__device__ __forceinline__ void p3_attn(Frame& F) {
    float lam, bsh;
    { const float* lq = F.in[I_LAMQK]; const float a = lq[F.lane] * lq[64 + F.lane], c = lq[128 + F.lane] * lq[192 + F.lane];
      lam = __expf(wave_sum(a)) - __expf(wave_sum(c)) + 0.2f;
      float mq = fmaxf(fabsf(F.in[I_QG][F.lane]), fabsf(F.in[I_QG][64 + F.lane])), mk = fmaxf(fabsf(F.in[I_KG][F.lane]), fabsf(F.in[I_KG][64 + F.lane]));
      float mb = fabsf(F.in[I_RELB][F.lane]); mb = fmaxf(mb, fabsf(F.in[I_RELB][64 + F.lane]));
#pragma unroll
      for (int o = 1; o < 64; o <<= 1) { mq = fmaxf(mq, __shfl_xor(mq, o)); mk = fmaxf(mk, __shfl_xor(mk, o)); mb = fmaxf(mb, __shfl_xor(mb, o)); }
      bsh = 64.0f * 0.125f * LOG2E * mq * mk * 1.02f + mb * LOG2E + 0.5f; }
    LAS float* lut = (LAS float*)(F.lds + LDSX_OFF);
    for (int u = F.vcu; u < 256; u += F.G) {
        const int bh = u >> 3, s = u & 7, b = bh >> 2, h = bh & 3;
        __syncthreads();
        if (F.tid < 256) { const int rel = F.tid - 191; lut[F.tid] = F.in[I_RELB][t5_bucket(rel) * NH + h] * LOG2E - bsh; }
        else if (F.tid < 256 + DV) lut[F.tid] = F.in[I_SUBG][F.tid - 256];
        LDS_WAIT(); __syncthreads();
        attn_unit2(F, b, h, s, lam, bsh);
        attn_unit2(F, b, h, 15 - s, lam, bsh);
    }
}

__device__ __forceinline__ int crow32(int r, int hi) { return (r & 3) + 8 * (r >> 2) + 4 * hi; }
template <bool DRY = false>
__device__ __forceinline__ void p5_router(Frame& F) {
    const bf16* hsrc = (const bf16*)(F.ws + WS_XN); unsigned char* HN = F.ws + (DRY ? 700 * MiB : WS_HN8);
    int* list = (int*)(F.ws + (DRY ? 720 * MiB : WS_LIST)); float* gates = (float*)(F.ws + (DRY ? 724 * MiB : WS_GATES));
    unsigned* cnt = (unsigned*)(F.ws + WS_CTL) + (DRY ? CW_CNT + 2048 : CW_CNT);
    LAS float* part = (LAS float*)F.lds;
    LAS float* ssq = (LAS float*)(F.lds + 65536);
    LAS float* rstdl = ssq + 512;
    LAS int* hist = (LAS int*)(F.lds + LDSX_OFF);
    LAS int* basel = hist + 32;
    LAS int* pendE = hist + 64;
    LAS float* pendG = (LAS float*)(hist + 320);
    const int lane = F.lane, wid = F.wave, r32 = lane & 31, hi5 = lane >> 5, kbase = wid * 128;
    bf16x8 bh[8], bl[8];
    { const bf16* wh = (const bf16*)(F.ws + WS_WRT) + r32 * DM + kbase + 8 * hi5;
#pragma unroll
      for (int ks = 0; ks < 8; ++ks) { bh[ks] = *(const GAS bf16x8*)(wh + 16 * ks); bl[ks] = *(const GAS bf16x8*)(wh + NE * DM + 16 * ks); } }
    const float rb = F.in[I_RB][r32];
    for (int tile = F.vcu; tile < NTOK / 64; tile += F.G) {
        const int tok0 = tile * 64;
        __syncthreads();
        if (F.tid < 32) hist[F.tid] = 0;
#pragma unroll
        for (int tt = 0; tt < 2; ++tt) {
            const bf16* hp = hsrc + (size_t)(tok0 + 32 * tt + r32) * DM + kbase + 8 * hi5;
            u32x4 v[8];
#pragma unroll
            for (int ks = 0; ks < 8; ++ks) v[ks] = *(const GAS u32x4*)(hp + 16 * ks);
            f32x16 acc;
#pragma unroll
            for (int r = 0; r < 16; ++r) acc[r] = 0.f;
            float ss = 0.f;
#pragma unroll
            for (int ks = 0; ks < 8; ++ks) {
#pragma unroll
                for (int i = 0; i < 4; ++i) { const float x0 = bflo(v[ks][i]), x1 = bfhi(v[ks][i]); ss += x0 * x0 + x1 * x1; }
                const bf16x8 ah = __builtin_bit_cast(bf16x8, v[ks]);
                acc = __builtin_amdgcn_mfma_f32_32x32x16_bf16(ah, bh[ks], acc, 0, 0, 0);
                acc = __builtin_amdgcn_mfma_f32_32x32x16_bf16(ah, bl[ks], acc, 0, 0, 0);
            }
            LAS float* pp = part + (tt * 8 + wid) * 1024;
#pragma unroll
            for (int r = 0; r < 16; ++r) pp[crow32(r, hi5) * 32 + r32] = acc[r];
            ss += __shfl_xor(ss, 32);
            if (lane < 32) ssq[(tt * 8 + wid) * 32 + lane] = ss;
        }
        LDS_WAIT(); __syncthreads();
#pragma unroll
        for (int tt = 0; tt < 2; ++tt)
#pragma unroll
            for (int rr = 0; rr < 2; ++rr) {
                const int tl = 4 * wid + 2 * rr + hi5, el = r32;
                float lg = 0.f, sq = 0.f;
#pragma unroll
                for (int w = 0; w < 8; ++w) { lg += part[((tt * 8 + w) * 32 + tl) * 32 + el]; sq += ssq[(tt * 8 + w) * 32 + tl]; }
                const float rstd = 1.0f / sqrtf(sq * (1.0f / DM) + EPS);
                if (el == 0) rstdl[tt * 32 + tl] = rstd;
                float v = lg * rstd + rb;
                float topv[4]; int topi[4];
#pragma unroll
                for (int k = 0; k < 4; ++k) {
                    float bv = v;
                    bv = fmaxf(bv, __builtin_bit_cast(float, __builtin_amdgcn_update_dpp(0, __builtin_bit_cast(int, bv), 0xB1, 0xF, 0xF, true)));
                    bv = fmaxf(bv, __builtin_bit_cast(float, __builtin_amdgcn_update_dpp(0, __builtin_bit_cast(int, bv), 0x4E, 0xF, 0xF, true)));
                    bv = fmaxf(bv, __builtin_bit_cast(float, __builtin_amdgcn_update_dpp(0, __builtin_bit_cast(int, bv), 0x141, 0xF, 0xF, true)));
                    bv = fmaxf(bv, __builtin_bit_cast(float, __builtin_amdgcn_update_dpp(0, __builtin_bit_cast(int, bv), 0x140, 0xF, 0xF, true)));
                    bv = fmaxf(bv, __shfl_xor(bv, 16));
                    const unsigned long long eqm = __ballot(v == bv);
                    const unsigned half = hi5 ? (unsigned)(eqm >> 32) : (unsigned)eqm;
                    const int bi = __builtin_ctz(half);
                    topv[k] = bv; topi[k] = bi; if (el == bi) v = -INFINITY;
                }
                const float e1 = __expf(topv[1] - topv[0]), e2 = __expf(topv[2] - topv[0]), e3 = __expf(topv[3] - topv[0]);
                const float inv = 1.0f / (1.0f + e1 + e2 + e3);
                if (el < 4) {
                    const int ee = el == 0 ? topi[0] : el == 1 ? topi[1] : el == 2 ? topi[2] : topi[3];
                    const float gg = (el == 0 ? 1.0f : el == 1 ? e1 : el == 2 ? e2 : e3) * inv;
                    const int slot = atomicAdd((int*)&hist[ee], 1);
                    const int idx = (tt * 32 + tl) * 4 + el;
                    pendE[idx] = ee | (slot << 8); pendG[idx] = gg;
                }
            }
        LDS_WAIT(); __syncthreads();
        if (F.tid < 32) basel[F.tid] = (int)__hip_atomic_fetch_add(cnt + 32 * F.tid, (unsigned)hist[F.tid], RLX_AGENT);
        {
            f32x4 gq[4];
#pragma unroll
            for (int q = 0; q < 4; ++q) gq[q] = *((const GAS f32x4*)F.in[I_G2] + lane * 4 + q);
#pragma unroll
            for (int jb = 0; jb < 2; ++jb) {
                u32x4 hx[4][2];
#pragma unroll
                for (int j = 0; j < 4; ++j) { const GAS u32x4* xr = (const GAS u32x4*)(hsrc + (size_t)(tok0 + wid * 8 + jb * 4 + j) * DM) + lane * 2; hx[j][0] = xr[0]; hx[j][1] = xr[1]; }
#pragma unroll
                for (int j = 0; j < 4; ++j) { const int tl = wid * 8 + jb * 4 + j; const float rstd = rstdl[tl];
                    u32x4 o;
#pragma unroll
                    for (int q = 0; q < 4; ++q) { const unsigned w0 = hx[j][q >> 1][(q & 1) * 2], w1 = hx[j][q >> 1][(q & 1) * 2 + 1];
                        o[q] = pk4_fp8(bflo(w0) * rstd * gq[q].x, bfhi(w0) * rstd * gq[q].y, bflo(w1) * rstd * gq[q].z, bfhi(w1) * rstd * gq[q].w); }
                    *((GAS u32x4*)(HN + (size_t)(tok0 + tl) * DM) + lane) = o; }
            }
        }
        LDS_WAIT(); __syncthreads();
        if (F.tid < 256) {
            const int pe = pendE[F.tid], ee = pe & 0xff, slot = pe >> 8; const int entry = (tok0 + (F.tid >> 2)) * 4 + (F.tid & 3);
            const int gs = basel[ee] + slot;
            list[ee * LIST_CAP + gs] = entry; gates[entry] = pendG[F.tid]; ((unsigned*)gates)[NTOK * TOPK + entry] = ((unsigned)ee << 16) | (unsigned)gs;
        }
    }
}

template <bool DRY = false>
__device__ __forceinline__ void p8_combine(Frame& F, int pre_lane) {
    const unsigned char* yb = F.ws + WS_YB; float* dout = DRY ? (float*)(F.ws + 700 * MiB) : F.out;
    const float* gates = (const float*)(F.ws + WS_GATES); const unsigned* eslot = (const unsigned*)(F.ws + WS_GATES) + NTOK * TOPK;
    LAS int* rbx = (LAS int*)(F.lds + LDSX_OFF);
    __syncthreads();
    if (F.tid < 32) { const int incl = pre_lane; const int prev = __shfl_up(incl, 1); rbx[F.tid] = F.tid ? prev : 0; }
    LDS_WAIT(); __syncthreads();
    const int gt = F.vcu * (NWAVES * 64) + F.tid, NGT = F.G * NWAVES * 64;
    for (int i = gt; i < NTOK * (DM / 8); i += NGT) {
        const int tok = i >> 7, c8 = (i & 127) * 8;
        const u32x4 hw = *(const GAS u32x4*)((const bf16*)(F.ws + WS_XN) + (size_t)tok * DM + c8);
        f32x4 a = (f32x4){bflo(hw.x), bfhi(hw.x), bflo(hw.y), bfhi(hw.y)}, b = (f32x4){bflo(hw.z), bfhi(hw.z), bflo(hw.w), bfhi(hw.w)};
        const u32x4 es = *(const GAS u32x4*)(eslot + tok * 4); const f32x4 gv = *(const GAS f32x4*)(gates + tok * 4);
        u32x2 w[4];
#pragma unroll
        for (int k = 0; k < 4; ++k) { const int row = 256 * rbx[es[k] >> 16] + (int)(es[k] & 0xffffu); w[k] = *(const GAS u32x2*)(yb + (size_t)row * DM + c8); }
        f32x4 sa = (f32x4){0.f, 0.f, 0.f, 0.f}, sb = (f32x4){0.f, 0.f, 0.f, 0.f};
#pragma unroll
        for (int k = 0; k < 4; ++k) { const float g = gv[k];
            const f32x2 p0 = __builtin_amdgcn_cvt_pk_f32_fp8(w[k].x, false), p1 = __builtin_amdgcn_cvt_pk_f32_fp8(w[k].x, true), p2 = __builtin_amdgcn_cvt_pk_f32_fp8(w[k].y, false), p3 = __builtin_amdgcn_cvt_pk_f32_fp8(w[k].y, true);
            sa.x += g * p0.x; sa.y += g * p0.y; sa.z += g * p1.x; sa.w += g * p1.y; sb.x += g * p2.x; sb.y += g * p2.y; sb.z += g * p3.x; sb.w += g * p3.y; }
        a = a + sa * YB_INV; b = b + sb * YB_INV;
        float* op = dout + (size_t)tok * DM + c8;
        *(GAS f32x4*)op = a; *(GAS f32x4*)(op + 4) = b;
    }
}

__device__ __forceinline__ void moe_table(Frame& F, int& pre_lane, int& cnt_lane, int& total_rb) {
    const unsigned* cnt = (const unsigned*)(F.ws + WS_CTL) + CW_CNT;
    int c = 0, rbn = 0;
    if (F.lane < 32) { c = (int)__hip_atomic_load(cnt + 32 * F.lane, RLX_AGENT); rbn = (c + 255) >> 8; }
    int p = rbn;
#pragma unroll
    for (int o = 1; o < 32; o <<= 1) { const int t = __shfl_up(p, o); if ((F.lane & 31) >= o) p += t; }
    total_rb = __builtin_amdgcn_readlane(p, 31);
    pre_lane = F.lane < 32 ? p : 0x7fffffff; cnt_lane = c;
}

constexpr int N_PHASES = 9;
__global__ void __launch_bounds__(NWAVES * 64, 2) fwd(Args args) {
    extern __shared__ __attribute__((aligned(16))) unsigned char lds_raw[];
    Frame F;
    F.lds = (LAS unsigned char*)lds_raw;
    F.tid = threadIdx.x; F.lane = F.tid & 63; F.wave = __builtin_amdgcn_readfirstlane(F.tid >> 6);
    F.G = gridDim.x; { const int bx = blockIdx.x; F.vcu = (F.G % 8 == 0) ? (bx % 8) * (F.G / 8) + bx / 8 : bx; }
    F.in = args.in; F.out = args.out; F.ws = args.ws;
    volatile LAS unsigned* MISC = (volatile LAS unsigned*)(F.lds + MISC_OFF);
    for (int u = F.tid; u < (LDS_BYTES - MISC_OFF) / 4; u += NWAVES * 64) MISC[u] = 0u;
    __syncthreads();
    unsigned* ctl = (unsigned*)(F.ws + WS_CTL);
#if MK_ONE_LAUNCH
    XcdBarrier bar = xcd_barrier_post(ctl + CW_BAR, MISC + 8);
#define GRID_BAR() xcd_barrier(bar)
#else
#define GRID_BAR() do { } while (0)
#endif
    const int lo = args.ph_lo, hi = args.ph_hi; const bool dry = args.dry != 0; const int sub = args.sub;
#define IN(k) (lo <= (k) && (k) < hi)
#define BOTH(k) (IN(k) && IN((k) + 1))

    const bool sched256 = (F.G == 256);
    if (IN(0)) { p0_prologue(F, !sched256); if (BOTH(0)) GRID_BAR(); }

    if (IN(1)) {
        const int c = (int)blockIdx.x; const bool typeA = c < 128; const int g3 = (c - 128) % 3;
        const int cfirst = typeA ? c * CVT_A : 128 * CVT_A + (c - 128) * CVT_B, ccount = typeA ? CVT_A : CVT_B;
        if (sched256 && !typeA && g3 == 0) { convert_items(F, cfirst, ccount); __syncthreads(); }
        pg8::DenseSched S; S.init(F.ws + WS_XN, F.ws + WS_WIN, NTOK, 2048, DM, F.G, c);
        pg8::EpiInProj E{(bf16*)(F.ws + WS_U), (bf16*)(F.ws + WS_QK), F.in[I_QG], F.in[I_KG]};
        const bool mid = sched256 && !typeA && g3 == 1;
        S.i0 = 0; S.i1 = mid ? 1 : (1 << 20);
        pg8::gemm_phase<pg8::EpiInProj, pg8::DenseSched, true, true>(F.lds, DM, S, E);
        if (mid) { __syncthreads(); convert_items(F, cfirst, ccount); __syncthreads();
            S.i0 = 1; S.i1 = 1 << 20;
            pg8::gemm_phase<pg8::EpiInProj, pg8::DenseSched, true, true>(F.lds, DM, S, E); }
        {
            pg8::DenseSched S2; S2.init(F.ws + WS_WIN + (size_t)2048 * DM * 2, F.ws + WS_XN, DATT, NTOK, DM, F.G, c);
            pg8::EpiVt E2{(bf16*)(F.ws + WS_VT)};
            pg8::gemm_phase<pg8::EpiVt, pg8::DenseSched, true, true>(F.lds, DM, S2, E2);
        }
        if (sched256 && (typeA || g3 == 2) && ccount > 0) { __syncthreads(); convert_items(F, cfirst, ccount); }
        if (BOTH(1)) GRID_BAR();
    }
    if (IN(3)) {
        const bool cv = sched256 && sub == 0; const int cfirst = 128 * CVT_A + 128 * CVT_B + F.vcu * CVT_3;
        if (cv && !(F.vcu & 1)) { convert_items(F, cfirst, CVT_3); }
        if (sub != 2) p3_conv(F); if (sub != 1) p3_attn(F);
        if (cv && (F.vcu & 1)) { __syncthreads(); convert_items(F, cfirst, CVT_3); }
        if (BOTH(3)) GRID_BAR(); }
    if (IN(4)) {
        pg8::DenseSched S; S.init(F.ws + WS_MIX, F.ws + WS_WOUT, NTOK, DM, DM, F.G, (int)blockIdx.x);
        pg8::EpiResBf16 E{F.in[I_X], (bf16*)(F.ws + WS_XN), DM};
        pg8::gemm_phase<pg8::EpiResBf16, pg8::DenseSched, true, true>(F.lds, DM, S, E);
        if (BOTH(4)) GRID_BAR();
    }
    if (IN(5)) { if (dry) p5_router<true>(F); else p5_router<false>(F); if (BOTH(5)) GRID_BAR(); }
    if (IN(6)) {
        int pre, cn, trb; moe_table(F, pre, cn, trb);
        pg8::MoeSched S; S.A = (const char*)(F.ws + WS_HN8); S.Bt = (const char*)(F.ws + WS_WGU); S.list = (const int*)(F.ws + WS_LIST); S.K = DM / 2; S.ncb = 8; S.total = trb * 8;
        S.G = F.G; S.c = (int)blockIdx.x; S.pre_lane = pre; S.cnt_lane = cn; S.gather = true; S.estride = (size_t)2 * DFF * DM;
        pg8::EpiSwiglu E{F.ws + WS_ACT, F.in[I_BGU]};
        pg8::gemm_phase<pg8::EpiSwiglu, pg8::MoeSched, true, true, true>(F.lds, DM / 2, S, E);
        if (BOTH(6)) GRID_BAR();
    }
    if (IN(7)) {
        int pre, cn, trb; moe_table(F, pre, cn, trb);
        pg8::MoeSched S; S.A = (const char*)(F.ws + WS_ACT); S.Bt = (const char*)(F.ws + WS_WD); S.list = (const int*)(F.ws + WS_LIST); S.K = DFF / 2; S.ncb = 4; S.total = trb * 4;
        S.G = F.G; S.c = (int)blockIdx.x; S.pre_lane = pre; S.cnt_lane = cn; S.gather = false; S.estride = (size_t)DM * DFF;
        pg8::EpiDown E{F.ws + WS_YB, F.in[I_BD]};
        pg8::gemm_phase<pg8::EpiDown, pg8::MoeSched, true, true, true>(F.lds, DFF / 2, S, E);
        if (BOTH(7)) GRID_BAR();
    }
    if (IN(8)) { int pre, cn, trb; moe_table(F, pre, cn, trb); if (dry) p8_combine<true>(F, pre); else p8_combine<false>(F, pre); }
#undef IN
#undef BOTH
}

extern "C" void kernel_launch(void* const* d_in, const int* in_sizes, int n_in, void* d_out, int out_size, void* d_ws, size_t ws_size, hipStream_t stream) {
    static int grid = 0;
    if (grid == 0) {
        if (n_in != 20 || in_sizes[0] != NTOK * DM || out_size != NTOK * DM || ws_size < WS_END) { fprintf(stderr, "kernel_launch: unexpected shapes (n_in %d, in0 %d, out %d, ws %zu)\n", n_in, n_in > 0 ? in_sizes[0] : -1, out_size, ws_size); grid = -1; return; }
        int dev = 0, cus = 0, per_cu = 0;
        if (hipGetDevice(&dev) != hipSuccess || hipDeviceGetAttribute(&cus, hipDeviceAttributeMultiprocessorCount, dev) != hipSuccess) { grid = -1; return; }
        if (hipFuncSetAttribute((const void*)fwd, hipFuncAttributeMaxDynamicSharedMemorySize, LDS_BYTES) != hipSuccess) { fprintf(stderr, "kernel_launch: hipFuncSetAttribute failed\n"); grid = -1; return; }
        if (hipOccupancyMaxActiveBlocksPerMultiprocessor(&per_cu, (const void*)fwd, NWAVES * 64, LDS_BYTES) != hipSuccess || per_cu < 1) { fprintf(stderr, "kernel_launch: occupancy query reports %d\n", per_cu); }
        (void)hipGetLastError();
        grid = cus;
    }
    if (grid < 0) return;
    (void)hipMemsetAsync((char*)d_ws + WS_CTL, 0, CTL_ZERO_BYTES, stream);
    Args a{};
    for (int i = 0; i < 20; ++i) a.in[i] = (const float*)d_in[i];
    a.out = (float*)d_out; a.ws = (unsigned char*)d_ws;
#if MK_ONE_LAUNCH
    a.ph_lo = 0; a.ph_hi = N_PHASES;
    hipLaunchKernelGGL(fwd, dim3(grid), dim3(NWAVES * 64), LDS_BYTES, stream, a);
#else
    for (int p = 0; p < N_PHASES; ++p) {
        a.ph_lo = p; a.ph_hi = p + 1; a.dry = 0; a.sub = 0;
        hipLaunchKernelGGL(fwd, dim3(grid), dim3(NWAVES * 64), LDS_BYTES, stream, a);
        if (p == PROBE_DUP) { a.dry = (p == 2 || p == 5 || p == 8) ? 1 : 0; a.sub = PROBE_SUB;
            for (int r = 0; r < PROBE_REP; ++r) hipLaunchKernelGGL(fwd, dim3(grid), dim3(NWAVES * 64), LDS_BYTES, stream, a); }
    }
#endif
}
```

```cpp
#include <hip/hip_runtime.h>
#include <cstdio>
#include <cstdint>

#ifndef PROBE_FULLREP
#define PROBE_FULLREP 0
#endif
#ifndef PROBE_DUP
#define PROBE_DUP -1
#endif
#ifndef PROBE_SUB
#define PROBE_SUB 0
#endif
#ifndef PROBE_REP
#define PROBE_REP 1
#endif
#ifndef MK_ONE_LAUNCH
#define MK_ONE_LAUNCH 1
#endif

#define GAS __attribute__((address_space(1)))
#define LAS __attribute__((address_space(3)))
typedef unsigned short bf16;
typedef short bf16x8 __attribute__((ext_vector_type(8)));
typedef float f32x4 __attribute__((ext_vector_type(4)));
typedef float f32x2 __attribute__((ext_vector_type(2)));
typedef float f32x16 __attribute__((ext_vector_type(16)));
typedef unsigned u32x4 __attribute__((ext_vector_type(4)));
typedef unsigned u32x2 __attribute__((ext_vector_type(2)));

constexpr int NB = 8, SEQ = 2048, DM = 1024, NTOK = NB * SEQ;
constexpr int DCONV = 512, CWID = 31, NH = 4, DH = 64, DV = 128, DATT = 512, DIN = 2560;
constexpr int NE = 32, TOPK = 4, DFF = 1024;
constexpr float EPS = 1e-5f;
constexpr float LOG2E = 1.4426950408889634f;
constexpr int LIST_CAP = NTOK;
constexpr int MAX_RB = NTOK * TOPK / 256 + NE;

constexpr size_t MiB = 1u << 20;
constexpr size_t WS_CTL = 0, CTL_ZERO_BYTES = 64 * 1024;
constexpr size_t WS_WIN = 2 * MiB;
constexpr size_t WS_WOUT = 8 * MiB;
constexpr size_t WS_WRT = 12 * MiB;
constexpr size_t WS_WGU = 16 * MiB;
constexpr size_t WS_WD = 144 * MiB;
constexpr size_t WS_HN8 = 176 * MiB;
constexpr size_t WS_XN = 208 * MiB;
constexpr size_t WS_U = 240 * MiB;
constexpr size_t WS_QK = 272 * MiB;
constexpr size_t WS_VT = 320 * MiB;
constexpr size_t WS_MIX = 336 * MiB;
constexpr size_t WS_LIST = 368 * MiB;
constexpr size_t WS_GATES = 370 * MiB;
constexpr size_t WS_ACT = 372 * MiB;
constexpr size_t WS_YB = 516 * MiB;
constexpr size_t WS_END = 644 * MiB;
constexpr int CW_BAR = 4096;
constexpr int CW_CNT = 8192;

constexpr int RING_BYTES = 131072;
constexpr int LDSX_OFF = RING_BYTES;
constexpr int MISC_OFF = RING_BYTES + 8192;
constexpr int LDS_BYTES = 147456;
constexpr int NWAVES = 8;

#define LDS_WAIT() asm volatile("s_waitcnt lgkmcnt(0)" ::: "memory")
#define VM_WAIT() asm volatile("s_waitcnt vmcnt(0)" ::: "memory")
#define RLX_AGENT __ATOMIC_RELAXED, __HIP_MEMORY_SCOPE_AGENT

__device__ __forceinline__ unsigned f2bf(float f) { unsigned u = __builtin_bit_cast(unsigned, f); return (u + 0x7fffu + ((u >> 16) & 1u)) >> 16; }
typedef __bf16 bf16x2_t __attribute__((ext_vector_type(2)));
__device__ __forceinline__ unsigned pk2c(float lo, float hi) { const f32x2 v = {lo, hi}; return __builtin_bit_cast(unsigned, __builtin_convertvector(v, bf16x2_t)); }
__device__ __forceinline__ unsigned pk2(float lo, float hi) { unsigned r; asm volatile("v_cvt_pk_bf16_f32 %0, %1, %2" : "=v"(r) : "v"(lo), "v"(hi)); return r; }
__device__ __forceinline__ unsigned pk4_fp8(float a, float b, float c, float d) { unsigned r = 0; r = __builtin_amdgcn_cvt_pk_fp8_f32(a, b, r, false); r = __builtin_amdgcn_cvt_pk_fp8_f32(c, d, r, true); return r; }
constexpr float W8_SCALE = 32.0f, W8_INV = 1.0f / 32.0f, YB_SCALE = 4.0f, YB_INV = 1.0f / 4.0f;
__device__ __forceinline__ float bf2f(unsigned short b) { return __builtin_bit_cast(float, (unsigned)b << 16); }
__device__ __forceinline__ float bflo(unsigned w) { return __builtin_bit_cast(float, w << 16); }
__device__ __forceinline__ float bfhi(unsigned w) { return __builtin_bit_cast(float, w & 0xffff0000u); }
__device__ __forceinline__ void st16_sc1(void* p, u32x4 v) { asm volatile("global_store_dwordx4 %0, %1, off sc1\n\ts_nop 3" :: "v"(p), "v"(v) : "memory"); }
__device__ __forceinline__ float wave_sum(float v) {
#pragma unroll
    for (int o = 1; o < 64; o <<= 1) v += __shfl_xor(v, o);
    return v;
}

namespace pg8 {
constexpr int LIST_LDS = LDSX_OFF + 6144;
constexpr int BIAS_LDS = LDSX_OFF + 4096;
constexpr int BM = 256, BK = 64, HALF = 128, HTB = HALF * BK * 2, STAGE_BYTES = 8 * HTB, NXCD = 8, WGM = 8;
__host__ __device__ __forceinline__ int lds_byte(int r, int c) { const int st = (r >> 4) * 2 + (c >> 5), rr = r & 15, cc = c & 31, ob = rr * 64 + cc * 2; return st * 1024 + (ob ^ (((ob >> 9) & 1) << 5)); }
__host__ __device__ __forceinline__ void stage_rc(int b, int& R, int& C) { const int st = b / 1024, sb = b % 1024, swz = sb ^ (((sb >> 9) & 1) << 5); R = (st >> 1) * 16 + swz / 64; C = (st & 1) * 32 + (swz % 64) / 2; }
__host__ __device__ __forceinline__ int perm32(int rho) { const int n = rho >> 4, i = rho & 15; return 8 * (i >> 2) + 4 * n + (i & 3); }

struct Unit { int pm, pn, e, rb, nvalid; };

struct DenseSched {
    static constexpr bool LDSLIST = false;
    const char* A; const char* Bt; int K; int nM, nN, nwg, G, c; int i0, i1;
    __device__ __forceinline__ void init(const void* A_, const void* Bt_, int M, int N, int K_, int G_, int c_) { A = (const char*)A_; Bt = (const char*)Bt_; K = K_; nM = M / BM; nN = N / BM; nwg = nM * nN; G = G_; c = c_; i0 = 0; i1 = 1 << 20; }
    __device__ __forceinline__ bool next(int i_, Unit& u) const {
        const int i = i_ + i0; if (i >= i1) return false;
        const long L = (long)i * G + c; if (L >= nwg) return false;
        int wgid = (int)L; { const int q = nwg / NXCD, r = nwg % NXCD, xcd = wgid % NXCD, off = wgid / NXCD; wgid = (xcd < r ? xcd * (q + 1) : r * (q + 1) + (xcd - r) * q) + off; }
        const int nig = WGM * nN, gid = wgid / nig, fm = gid * WGM, gsz = (nM - fm) < WGM ? (nM - fm) : WGM;
        u.pm = fm + ((wgid % nig) % gsz); u.pn = (wgid % nig) / gsz; u.e = 0; u.rb = 0; u.nvalid = 256; return true;
    }
    __device__ __forceinline__ const char* a_base() const { return A; }
    __device__ __forceinline__ void a_offsets(const Unit& u, const int (&Rr)[2], const int (&Cc)[2], unsigned (&o)[2][2]) const {
#pragma unroll
        for (int h = 0; h < 2; ++h)
#pragma unroll
            for (int i = 0; i < 2; ++i) o[h][i] = (unsigned)((u.pm * BM + h * HALF + Rr[i]) * K + Cc[i]) * 2u;
    }
    __device__ __forceinline__ const char* b_ptr(const Unit& u) const { return Bt + (size_t)u.pn * BM * K * 2; }
};

template <bool gather>
struct MoeSched {
    static constexpr bool LDSLIST = gather;
    const char* A; const char* Bt; const int* list; int K; int ncb; int total; int G, c; int pre_lane, cnt_lane; size_t estride;
    __device__ __forceinline__ bool next(int i, Unit& u) const {
        const int L = i * G + c; if (L >= total) return false;
        const int R = L / ncb, cb = L - R * ncb;
        const unsigned long long m = __ballot(R >= pre_lane);
        const int e = __popcll(m);
        const int prev = e ? __builtin_amdgcn_readlane(pre_lane, e - 1) : 0;
        const int cnt = __builtin_amdgcn_readlane(cnt_lane, e);
        u.pm = R; u.pn = cb; u.e = e; u.rb = R - prev; const int left = cnt - u.rb * 256; u.nvalid = left < 256 ? left : 256; return true;
    }
    __device__ __forceinline__ const char* a_base() const { return A; }
    __device__ __forceinline__ void a_offsets(const Unit& u, const int (&Rr)[2], const int (&Cc)[2], unsigned (&o)[2][2]) const {
#pragma unroll
        for (int h = 0; h < 2; ++h)
#pragma unroll
            for (int i = 0; i < 2; ++i) {
                const int r = h * HALF + Rr[i]; int row;
                if (gather) { const int v = list[u.e * LIST_CAP + u.rb * 256 + r]; row = r < u.nvalid ? (v >> 2) : 0; }
                else row = u.pm * BM + r;
                o[h][i] = (unsigned)(row * K + Cc[i]) * 2u;
            }
    }
    __device__ __forceinline__ const int* list_src(const Unit& u) const { return list + u.e * LIST_CAP + u.rb * 256; }
    __device__ __forceinline__ void a_offsets_lds(const Unit& u, const int (&Rr)[2], const int (&Cc)[2], const LAS int* sl, unsigned (&o)[2][2]) const {
#pragma unroll
        for (int h = 0; h < 2; ++h)
#pragma unroll
            for (int i = 0; i < 2; ++i) { const int r = h * HALF + Rr[i]; const int v = sl[r]; const int row = r < u.nvalid ? (v >> 2) : 0; o[h][i] = (unsigned)(row * K + Cc[i]) * 2u; }
    }
    __device__ __forceinline__ const char* b_ptr(const Unit& u) const { return Bt + (size_t)u.e * estride + (size_t)u.pn * BM * K * 2; }
};

struct EpiInProj {
    static constexpr bool PERM = true, BIAS = false;
    bf16* U; bf16* QK; const float* qg; const float* kg;
    __device__ __forceinline__ void operator()(const f32x4 (&acc)[2][2][4][2], const Unit& u, int wr, int wc, int fr, int fq, const LAS float* sb) const {
        const int row0 = u.pm * BM + wr * 64 + fr;
        if (u.pn < 4) {
            const int col0 = u.pn * 128 + wc * 32 + 8 * fq;
#pragma unroll
            for (int ai = 0; ai < 2; ++ai)
#pragma unroll
                for (int m = 0; m < 4; ++m) {
                    f32x2 o[4];
#pragma unroll
                    for (int n = 0; n < 2; ++n)
#pragma unroll
                        for (int j = 0; j < 2; ++j) { const f32x4 a4 = acc[ai][0][m][n], g4 = acc[ai][1][m][n];
                            const f32x2 gs = (f32x2){g4[2 * j], g4[2 * j + 1]} * (-LOG2E * W8_INV);
                            const f32x2 d = (f32x2){__builtin_amdgcn_exp2f(gs[0]), __builtin_amdgcn_exp2f(gs[1])} + 1.0f;
                            o[2 * n + j] = ((f32x2){a4[2 * j], a4[2 * j + 1]} * W8_INV) * (f32x2){__builtin_amdgcn_rcpf(d[0]), __builtin_amdgcn_rcpf(d[1])}; }
                    u32x4 w; w.x = pk2(o[0][0], o[0][1]); w.y = pk2(o[1][0], o[1][1]); w.z = pk2(o[2][0], o[2][1]); w.w = pk2(o[3][0], o[3][1]);
                    st16_sc1(U + (size_t)(row0 + ai * HALF + m * 16) * DCONV + col0, w);
                }
        } else {
            const bool isq = u.pn < 6; const float sc = isq ? 0.125f * LOG2E : 1.0f;
            const float* gp = (isq ? qg : kg) + (wc & 1) * 64 + 8 * fq;
            f32x4 gv[2][2];
#pragma unroll
            for (int bj = 0; bj < 2; ++bj)
#pragma unroll
                for (int n = 0; n < 2; ++n) gv[bj][n] = *(const f32x4*)(gp + 32 * bj + 4 * n);
            const int col0 = (u.pn - 4) * 256 + wc * 64 + 8 * fq;
#pragma unroll
            for (int ai = 0; ai < 2; ++ai)
#pragma unroll
                for (int m = 0; m < 4; ++m) {
                    float ss = 0.f;
#pragma unroll
                    for (int bj = 0; bj < 2; ++bj)
#pragma unroll
                        for (int n = 0; n < 2; ++n) { const f32x4 v = acc[ai][bj][m][n]; ss += (v[0] * v[0] + v[1] * v[1]) + (v[2] * v[2] + v[3] * v[3]); }
                    ss += __shfl_xor(ss, 16); ss += __shfl_xor(ss, 32);
                    const float rstd = (sc * W8_INV) / sqrtf(ss * (W8_INV * W8_INV / 64.0f) + EPS);
                    bf16* rowp = QK + (size_t)(row0 + ai * HALF + m * 16) * DM + col0;
#pragma unroll
                    for (int bj = 0; bj < 2; ++bj) { const f32x4 v0 = acc[ai][bj][m][0] * gv[bj][0] * rstd, v1 = acc[ai][bj][m][1] * gv[bj][1] * rstd;
                        u32x4 w; w.x = pk2(v0[0], v0[1]); w.y = pk2(v0[2], v0[3]); w.z = pk2(v1[0], v1[1]); w.w = pk2(v1[2], v1[3]);
                        st16_sc1(rowp + 32 * bj, w); }
                }
        }
    }
};
struct EpiVt {
    static constexpr bool PERM = true, BIAS = false;
    bf16* Vt;
    __device__ __forceinline__ void operator()(const f32x4 (&acc)[2][2][4][2], const Unit& u, int wr, int wc, int fr, int fq, const LAS float* sb) const {
        const int row0 = u.pm * BM + wr * 64 + fr; const int tok0 = u.pn * BM; const int b = tok0 / SEQ, s0 = (tok0 % SEQ) + wc * 32 + 8 * fq;
#pragma unroll
        for (int ai = 0; ai < 2; ++ai)
#pragma unroll
            for (int m = 0; m < 4; ++m) { bf16* rowp = Vt + ((size_t)b * DATT + row0 + ai * HALF + m * 16) * SEQ + s0;
#pragma unroll
                for (int bj = 0; bj < 2; ++bj) { const f32x4 v0 = acc[ai][bj][m][0] * W8_INV, v1 = acc[ai][bj][m][1] * W8_INV;
                    u32x4 w; w.x = pk2(v0[0], v0[1]); w.y = pk2(v0[2], v0[3]); w.z = pk2(v1[0], v1[1]); w.w = pk2(v1[2], v1[3]);
                    st16_sc1(rowp + bj * HALF, w); } }
    }
};
struct EpiResBf16 {
    static constexpr bool PERM = true, BIAS = false;
    const float* base; bf16* out; int ldc;
    __device__ __forceinline__ void operator()(const f32x4 (&acc)[2][2][4][2], const Unit& u, int wr, int wc, int fr, int fq, const LAS float* sb) const {
        const int col0 = u.pn * BM + wc * 32 + 8 * fq;
#pragma unroll
        for (int ai = 0; ai < 2; ++ai)
#pragma unroll
            for (int m = 0; m < 4; ++m) { const size_t off = (size_t)(u.pm * BM + ai * HALF + wr * 64 + m * 16 + fr) * ldc + col0;
#pragma unroll
                for (int bj = 0; bj < 2; ++bj) { const f32x4 b0 = *(const f32x4*)(base + off + bj * HALF), b1 = *(const f32x4*)(base + off + bj * HALF + 4);
                    const f32x4 v0 = b0 + acc[ai][bj][m][0], v1 = b1 + acc[ai][bj][m][1];
                    u32x4 w; w.x = pk2(v0[0], v0[1]); w.y = pk2(v0[2], v0[3]); w.z = pk2(v1[0], v1[1]); w.w = pk2(v1[2], v1[3]);
                    *(u32x4*)(out + off + bj * HALF) = w; } }
    }
};
struct EpiSwiglu {
    static constexpr bool PERM = true, BIAS = true;
    unsigned char* act; const float* bgu;
    __device__ __forceinline__ const float* bias_src(const Unit& u) const { return bgu + (size_t)u.e * 2048 + u.pn * 256; }
    __device__ __forceinline__ void operator()(const f32x4 (&acc)[2][2][4][2], const Unit& u, int wr, int wc, int fr, int fq, const LAS float* sb) const {
        const int row0 = u.pm * BM + wr * 64 + fr; const int acol0 = u.pn * 128 + wc * 32 + 8 * fq;
        const LAS float* bp = sb + wc * 64 + 16 * fq;
        f32x4 bb[4];
#pragma unroll
        for (int i = 0; i < 4; ++i) bb[i] = *(const LAS f32x4*)(bp + 4 * i);
        constexpr float CS = -1.702f * LOG2E, CI = 1.0f / CS;
        f32x2 bg[4], bl[4];
#pragma unroll
        for (int i = 0; i < 4; ++i) { bg[i] = (f32x2){bb[i][0], bb[i][2]} * CS; bl[i] = ((f32x2){bb[i][1], bb[i][3]} + 1.0f) * CI; }
#pragma unroll
        for (int ai = 0; ai < 2; ++ai)
#pragma unroll
            for (int m = 0; m < 4; ++m) {
                f32x2 o[4];
#pragma unroll
                for (int n = 0; n < 2; ++n)
#pragma unroll
                    for (int j = 0; j < 2; ++j) {
                        const f32x4 ag = acc[ai][0][m][n], al = acc[ai][1][m][n];
                        f32x2 gs = __builtin_elementwise_fma((f32x2){ag[2 * j], ag[2 * j + 1]}, (f32x2){W8_INV * CS, W8_INV * CS}, bg[2 * n + j]);
                        f32x2 ls = __builtin_elementwise_fma((f32x2){al[2 * j], al[2 * j + 1]}, (f32x2){W8_INV * CI, W8_INV * CI}, bl[2 * n + j]);
                        gs[0] = fmaxf(gs[0], 7.0f * CS); gs[1] = fmaxf(gs[1], 7.0f * CS);
                        ls[0] = __builtin_amdgcn_fmed3f(ls[0], 8.0f * CI, -6.0f * CI); ls[1] = __builtin_amdgcn_fmed3f(ls[1], 8.0f * CI, -6.0f * CI);
                        f32x2 d = (f32x2){__builtin_amdgcn_exp2f(gs[0]), __builtin_amdgcn_exp2f(gs[1])} + 1.0f;
                        const f32x2 sg = {__builtin_amdgcn_rcpf(d[0]), __builtin_amdgcn_rcpf(d[1])};
                        o[2 * n + j] = (gs * ls) * sg;
                    }
                u32x2 w; w.x = pk4_fp8(o[0][0], o[0][1], o[1][0], o[1][1]); w.y = pk4_fp8(o[2][0], o[2][1], o[3][0], o[3][1]);
                *(u32x2*)(act + (size_t)(row0 + ai * HALF + m * 16) * DFF + acol0) = w;
            }
    }
};
struct EpiDown {
    static constexpr bool PERM = true, BIAS = true;
    unsigned char* yb; const float* bd;
    __device__ __forceinline__ const float* bias_src(const Unit& u) const { return bd + (size_t)u.e * DM + u.pn * BM; }
    __device__ __forceinline__ void operator()(const f32x4 (&acc)[2][2][4][2], const Unit& u, int wr, int wc, int fr, int fq, const LAS float* sb) const {
        const int col0 = u.pn * BM + wc * 64 + 16 * fq; const int row0 = u.pm * BM + wr * 64 + fr;
        f32x4 bv[2][2];
#pragma unroll
        for (int bj = 0; bj < 2; ++bj)
#pragma unroll
            for (int n = 0; n < 2; ++n) bv[bj][n] = *(const LAS f32x4*)(sb + wc * 64 + 16 * fq + 8 * bj + 4 * n) * YB_SCALE;
#pragma unroll
        for (int ai = 0; ai < 2; ++ai)
#pragma unroll
            for (int m = 0; m < 4; ++m) { unsigned char* rowp = yb + (size_t)(row0 + ai * HALF + m * 16) * DM + col0;
                u32x4 w;
#pragma unroll
                for (int bj = 0; bj < 2; ++bj) { const f32x4 v0 = acc[ai][bj][m][0] * (W8_INV * YB_SCALE) + bv[bj][0], v1 = acc[ai][bj][m][1] * (W8_INV * YB_SCALE) + bv[bj][1];
                    w[2 * bj] = pk4_fp8(v0[0], v0[1], v0[2], v0[3]); w[2 * bj + 1] = pk4_fp8(v1[0], v1[1], v1[2], v1[3]); }
                st16_sc1(rowp, w); }
    }
};

typedef int i32x4 __attribute__((ext_vector_type(4)));
typedef int i32x8 __attribute__((ext_vector_type(8)));
template <class Epi, class Sched, bool ALIGN_EPI, bool SP2, bool FP8 = false, bool BTILED = FP8>
__device__ __forceinline__ void gemm_phase(LAS unsigned char* lds, const int K, const Sched& S, const Epi& E) {
    const int tid = threadIdx.x, wid = __builtin_amdgcn_readfirstlane(tid >> 6), lane = tid & 63, wr = wid >> 2, wc = wid & 3, fr = lane & 15, fq = lane >> 4;
    const int nt = K / BK;
    int Rr[2], Cc[2]; unsigned voffB[2];
#pragma unroll
    for (int i = 0; i < 2; ++i) { int R, C; stage_rc(tid * 16 + i * 8192, R, C); const int Rb = Epi::PERM ? ((R & ~31) + perm32(R & 31)) : R;
        Rr[i] = R; Cc[i] = C; voffB[i] = BTILED ? (unsigned)(Rb * 128 + C * 2) : (unsigned)(Rb * K + C) * 2u; }
    const size_t kstep = (size_t)(BK * 2);
    const size_t hstep = (size_t)HALF * K * 2;
    const size_t kstepB = BTILED ? (size_t)32768 : kstep, hstepB = BTILED ? (size_t)16384 : hstep;
    const unsigned ldsw = (unsigned)wid * 1024u;
    const int aoff = lds_byte(wr * 64 + fr, fq * 8), boff = lds_byte(wc * 32 + fr, fq * 8);
#define PG8_SA(b, h) (((b) * 2 + (h)) * HTB)
#define PG8_SB(b, h) ((4 + (b) * 2 + (h)) * HTB)
#define PG8_STAGE(bufoff, gbase, voff) do { _Pragma("unroll") for (int _i = 0; _i < 2; ++_i) \
        __builtin_amdgcn_global_load_lds((const unsigned*)((const char*)(gbase) + (voff)[_i]), (LAS unsigned*)(lds + (bufoff) + ldsw + _i * 8192), 16, 0, 0); } while (0)
#define PG8_LD8(p) __builtin_shufflevector(*(const LAS i32x4*)(p), *(const LAS i32x4*)((p) + 1024), 0, 1, 2, 3, 4, 5, 6, 7)
#define PG8_LDA(dst, b, h) do { _Pragma("unroll") for (int m = 0; m < 4; ++m) dst[m] = PG8_LD8(lds + PG8_SA(b, h) + aoff + m * 2048); } while (0)
#define PG8_LDB(dst, b, h) do { _Pragma("unroll") for (int n = 0; n < 2; ++n) dst[n] = PG8_LD8(lds + PG8_SB(b, h) + boff + n * 2048); } while (0)
#define PG8_LO(x) __builtin_bit_cast(bf16x8, __builtin_shufflevector(x, x, 0, 1, 2, 3))
#define PG8_HI(x) __builtin_bit_cast(bf16x8, __builtin_shufflevector(x, x, 4, 5, 6, 7))
#define PG8_MMA(ai, bj, At, Bt) do { if (FP8 && (ai) == 1 && cur.nvalid <= HALF) break;     \
        __builtin_amdgcn_s_setprio(1); _Pragma("unroll") for (int m = 0; m < 4; ++m) _Pragma("unroll") for (int n = 0; n < 2; ++n) { \
        if constexpr (FP8) asm volatile("v_mfma_f32_16x16x128_f8f6f4 %0, %1, %2, %0" : "+v"(acc[ai][bj][m][n]) : "v"(Bt[n]), "v"(At[m])); \
        else { acc[ai][bj][m][n] = __builtin_amdgcn_mfma_f32_16x16x32_bf16(PG8_LO(Bt[n]), PG8_LO(At[m]), acc[ai][bj][m][n], 0, 0, 0); \
               acc[ai][bj][m][n] = __builtin_amdgcn_mfma_f32_16x16x32_bf16(PG8_HI(Bt[n]), PG8_HI(At[m]), acc[ai][bj][m][n], 0, 0, 0); } } \
        __builtin_amdgcn_s_setprio(0); } while (0)
#define PG8_WAIT_V(n) asm volatile("s_waitcnt vmcnt(" #n ")" ::: "memory")
#define PG8_WAIT_L(n) asm volatile("s_waitcnt lgkmcnt(" #n ")" ::: "memory")
#define PG8_BAR __builtin_amdgcn_s_barrier()
#define PG8_SCHED __builtin_amdgcn_sched_barrier(0)
    Unit cur, nxt; int ui = 0;
    if (!S.next(0, cur)) return;
    f32x4 acc[2][2][4][2];
#pragma unroll
    for (int a = 0; a < 2; ++a)
#pragma unroll
        for (int b = 0; b < 2; ++b)
#pragma unroll
            for (int m = 0; m < 4; ++m)
#pragma unroll
                for (int n = 0; n < 2; ++n) acc[a][b][m][n] = (f32x4){0.f, 0.f, 0.f, 0.f};
    i32x8 At[4], B0[2], B1[2];
    const char* gA = S.a_base();
    unsigned cvA[2][2], nvA[2][2];
    S.a_offsets(cur, Rr, Cc, cvA);
    const char* cB = S.b_ptr(cur);
    if constexpr (SP2) {
        PG8_STAGE(PG8_SB(0, 0), cB, voffB); PG8_STAGE(PG8_SB(0, 1), cB + hstepB, voffB); PG8_STAGE(PG8_SA(0, 0), gA, cvA[0]); PG8_STAGE(PG8_SA(0, 1), gA, cvA[1]);
        if (wr == 1) PG8_BAR;
        PG8_WAIT_V(2); PG8_BAR;
        PG8_STAGE(PG8_SB(1, 0), cB + kstepB, voffB); PG8_STAGE(PG8_SA(1, 0), gA + kstep, cvA[0]); PG8_STAGE(PG8_SB(1, 1), cB + hstepB + kstepB, voffB);
        PG8_WAIT_V(6); PG8_BAR;
    } else {
        PG8_STAGE(PG8_SB(0, 0), cB, voffB); PG8_STAGE(PG8_SA(0, 0), gA, cvA[0]); PG8_STAGE(PG8_SB(0, 1), cB + hstepB, voffB); PG8_STAGE(PG8_SA(0, 1), gA, cvA[1]);
        if (wr == 1) PG8_BAR;
        PG8_WAIT_V(4); PG8_BAR;
        PG8_STAGE(PG8_SB(1, 0), cB + kstepB, voffB); PG8_STAGE(PG8_SA(1, 0), gA + kstep, cvA[0]); PG8_STAGE(PG8_SB(1, 1), cB + hstepB + kstepB, voffB);
        PG8_WAIT_V(6); PG8_BAR;
    }
    for (;;) {
        const bool has_next = S.next(ui + 1, nxt);
        const char* nB = cB;
        if (has_next && !Sched::LDSLIST) { S.a_offsets(nxt, Rr, Cc, nvA); nB = S.b_ptr(nxt); }
        else {
#pragma unroll
            for (int h = 0; h < 2; ++h)
#pragma unroll
                for (int i = 0; i < 2; ++i) nvA[h][i] = cvA[h][i];
        }
        if constexpr (Sched::LDSLIST) { if (has_next) { nB = S.b_ptr(nxt);
            if (wid == 1) __builtin_amdgcn_global_load_lds((const unsigned*)(S.list_src(nxt) + 4 * lane), (LAS unsigned*)(lds + LIST_LDS + ((ui + 1) & 1) * 1024), 16, 0, 0); } }
        if constexpr (Epi::BIAS) { if (wid == 0) __builtin_amdgcn_global_load_lds((const unsigned*)(E.bias_src(cur) + 4 * lane), (LAS unsigned*)(lds + BIAS_LDS + (ui & 1) * 1024), 16, 0, 0); }
        for (int t = 0; t < nt; t += 2) {
            const bool last = (t == nt - 2);
            if constexpr (Sched::LDSLIST) { if (has_next && t == nt - 4) S.a_offsets_lds(nxt, Rr, Cc, (const LAS int*)(lds + LIST_LDS + ((ui + 1) & 1) * 1024), nvA); }
            const char* a1 = gA + (size_t)(t + 1) * kstep;
            const char* a2 = last ? gA : gA + (size_t)(t + 2) * kstep; const char* b2 = last ? nB : cB + (size_t)(t + 2) * kstepB;
            const char* a3 = a2 + kstep; const char* b3 = b2 + kstepB;
            unsigned o2[2][2];
#pragma unroll
            for (int h = 0; h < 2; ++h)
#pragma unroll
                for (int i = 0; i < 2; ++i) o2[h][i] = last ? nvA[h][i] : cvA[h][i];
            if constexpr (SP2) {
            PG8_LDB(B0, 0, 0); PG8_LDB(B1, 0, 1); PG8_SCHED; PG8_LDA(At, 0, 0); PG8_STAGE(PG8_SA(1, 1), a1, cvA[1]);
            PG8_WAIT_V(8); PG8_WAIT_L(0); PG8_BAR; PG8_MMA(0, 0, At, B0); PG8_MMA(0, 1, At, B1); PG8_BAR; PG8_SCHED;
            PG8_LDA(At, 0, 1); PG8_STAGE(PG8_SB(0, 0), b2, voffB); PG8_STAGE(PG8_SB(0, 1), b2 + hstepB, voffB); PG8_STAGE(PG8_SA(0, 0), a2, o2[0]);
            PG8_WAIT_V(8); PG8_WAIT_L(0); PG8_BAR; PG8_MMA(1, 0, At, B0); PG8_MMA(1, 1, At, B1); PG8_BAR; PG8_SCHED;
            PG8_LDB(B0, 1, 0); PG8_LDB(B1, 1, 1); PG8_SCHED; PG8_LDA(At, 1, 0); PG8_STAGE(PG8_SA(0, 1), a2, o2[1]);
            PG8_WAIT_V(8); PG8_WAIT_L(0); PG8_BAR; PG8_MMA(0, 0, At, B0); PG8_MMA(0, 1, At, B1); PG8_BAR; PG8_SCHED;
            PG8_LDA(At, 1, 1); PG8_STAGE(PG8_SB(1, 0), b3, voffB); PG8_STAGE(PG8_SB(1, 1), b3 + hstepB, voffB); PG8_STAGE(PG8_SA(1, 0), a3, o2[0]);
            PG8_WAIT_V(8); PG8_WAIT_L(0); PG8_BAR; PG8_MMA(1, 0, At, B0); PG8_MMA(1, 1, At, B1); PG8_BAR; PG8_SCHED;
            } else {
            PG8_LDB(B0, 0, 0); PG8_SCHED; PG8_LDA(At, 0, 0); PG8_STAGE(PG8_SA(1, 1), a1, cvA[1]);
            PG8_WAIT_L(8); PG8_BAR; PG8_WAIT_L(0); PG8_MMA(0, 0, At, B0); PG8_BAR; PG8_SCHED;
            PG8_LDB(B1, 0, 1); PG8_STAGE(PG8_SB(0, 0), b2, voffB);
            PG8_BAR; PG8_WAIT_L(0); PG8_MMA(0, 1, At, B1); PG8_BAR;
            PG8_LDA(At, 0, 1); PG8_STAGE(PG8_SA(0, 0), a2, o2[0]);
            PG8_BAR; PG8_WAIT_L(0); PG8_MMA(1, 0, At, B0); PG8_BAR; PG8_SCHED;
            PG8_STAGE(PG8_SB(0, 1), b2 + hstepB, voffB);
            PG8_WAIT_V(6); PG8_BAR; PG8_MMA(1, 1, At, B1); PG8_BAR;
            PG8_LDB(B0, 1, 0); PG8_SCHED; PG8_LDA(At, 1, 0); PG8_STAGE(PG8_SA(0, 1), a2, o2[1]);
            PG8_WAIT_L(8); PG8_BAR; PG8_WAIT_L(0); PG8_MMA(0, 0, At, B0); PG8_BAR; PG8_SCHED;
            PG8_LDB(B1, 1, 1); PG8_STAGE(PG8_SB(1, 0), b3, voffB);
            PG8_BAR; PG8_WAIT_L(0); PG8_MMA(0, 1, At, B1); PG8_BAR;
            PG8_LDA(At, 1, 1); PG8_STAGE(PG8_SA(1, 0), a3, o2[0]);
            PG8_BAR; PG8_WAIT_L(0); PG8_MMA(1, 0, At, B0); PG8_BAR; PG8_SCHED;
            PG8_STAGE(PG8_SB(1, 1), b3 + hstepB, voffB);
            PG8_WAIT_V(6); PG8_BAR; PG8_MMA(1, 1, At, B1); PG8_BAR;
            }
        }
        if constexpr (ALIGN_EPI) { if (wr == 0) PG8_BAR; }
        if constexpr (FP8) asm volatile("s_nop 15\n\ts_nop 15" ::: "memory");
        E(acc, cur, wr, wc, fr, fq, (const LAS float*)(lds + BIAS_LDS + (ui & 1) * 1024));
        if (!has_next) break;
#pragma unroll
        for (int a = 0; a < 2; ++a)
#pragma unroll
            for (int b = 0; b < 2; ++b)
#pragma unroll
                for (int m = 0; m < 4; ++m)
#pragma unroll
                    for (int n = 0; n < 2; ++n) acc[a][b][m][n] = (f32x4){0.f, 0.f, 0.f, 0.f};
        cur = nxt; cB = nB; ++ui;
#pragma unroll
        for (int h = 0; h < 2; ++h)
#pragma unroll
            for (int i = 0; i < 2; ++i) cvA[h][i] = nvA[h][i];
        if constexpr (ALIGN_EPI) { if (wr == 1) PG8_BAR; }
    }
    PG8_WAIT_V(0);
    if constexpr (!ALIGN_EPI) { if (wr == 0) PG8_BAR; }
    PG8_BAR;
#undef PG8_SA
#undef PG8_SB
#undef PG8_STAGE
#undef PG8_LDA
#undef PG8_LDB
#undef PG8_MMA
#undef PG8_LO
#undef PG8_HI
#undef PG8_LD8
#undef PG8_WAIT_V
#undef PG8_WAIT_L
#undef PG8_BAR
#undef PG8_SCHED
}
}

#define XB_TMO      128
#define XB_XCNT(j)  (256  + 64 * (j))
#define XB_XSUB(j)  (1280 + 64 * (j))
#define XB_XGEN(j)  (2304 + 64 * (j))
#define XB_TOP      3328
#define XB_TOPGEN   3392
#define XCD_BAR_WORDS 3456
#define XB_SPIN_CAP (1u << 18)
__device__ __forceinline__ unsigned xb_ld(unsigned* p)              { return __hip_atomic_load(p, __ATOMIC_RELAXED, __HIP_MEMORY_SCOPE_AGENT); }
__device__ __forceinline__ unsigned xb_add(unsigned* p, unsigned v) { return __hip_atomic_fetch_add(p, v, __ATOMIC_RELAXED, __HIP_MEMORY_SCOPE_AGENT); }
__device__ __forceinline__ unsigned xb_xcc_id() { return (unsigned)__builtin_amdgcn_s_getreg((3 << 11) | 20) & 0xFu; }
#define XB_SPIN(cond, bar) do { unsigned _sp = 0; while (cond) { __builtin_amdgcn_s_sleep(1); \
    if ((++_sp & 255u) == 0u) { if (xb_ld(&(bar)[XB_TMO])) break; if (_sp > XB_SPIN_CAP) { atomicAdd(&(bar)[XB_TMO], 1u); break; } } } } while (0)
struct XcdBarrier { unsigned* bar; unsigned x; volatile LAS unsigned* st; };
__device__ __forceinline__ XcdBarrier xcd_barrier_post(unsigned* bar, volatile LAS unsigned* st) {
    XcdBarrier b; b.bar = bar; b.x = xb_xcc_id(); b.st = st;
    if (threadIdx.x == 0) (void)xb_add(&bar[XB_XCNT(b.x)], 1u);
    return b;
}
__device__ __forceinline__ void xcd_barrier_complete(unsigned* bar, unsigned x, unsigned& nloc, unsigned& nx) {
    const unsigned G = gridDim.x * gridDim.y * gridDim.z;
    unsigned sum, cnt, mine, sp = 0u;
    for (;;) {
        sum = 0u; cnt = 0u; mine = 0u;
#pragma unroll
        for (unsigned j = 0; j < 16; ++j) { const unsigned c = xb_ld(&bar[XB_XCNT(j)]); sum += c; cnt += (c > 0u) ? 1u : 0u; mine = (j == x) ? c : mine; }
        if (sum == G) break;
        __builtin_amdgcn_s_sleep(1);
        if ((++sp & 255u) == 0u) { if (xb_ld(&bar[XB_TMO])) break; if (sp > XB_SPIN_CAP) { atomicAdd(&bar[XB_TMO], 1u); break; } }
    }
    nloc = mine > 0u ? mine : 1u; nx = cnt > 0u ? cnt : 1u;
}
__device__ __forceinline__ void xcd_barrier(const XcdBarrier& b) {
    asm volatile("s_waitcnt vmcnt(0)" ::: "memory");
    __syncthreads();
    if (threadIdx.x == 0) {
        unsigned* bar = b.bar;
        __builtin_amdgcn_s_waitcnt(0);
        unsigned nloc = b.st[0], nx = b.st[1];
        if (nloc == 0u) { xcd_barrier_complete(bar, b.x, nloc, nx); b.st[0] = nloc; b.st[1] = nx; }
        const unsigned target = b.st[2] + 1u; b.st[2] = target;
        const unsigned old = xb_add(&bar[XB_XSUB(b.x)], 1u);
        const unsigned gen = old / nloc;
        if (old + 1u == (gen + 1u) * nloc) {
            __builtin_amdgcn_fence(__ATOMIC_RELEASE, "agent");
            asm volatile("s_waitcnt vmcnt(0)" ::: "memory");
            const unsigned og = xb_add(&bar[XB_TOP], 1u);
            const unsigned tg = og / nx;
            if (og + 1u == (tg + 1u) * nx) xb_add(&bar[XB_TOPGEN], 1u);
        }
        XB_SPIN(xb_ld(&bar[XB_TOPGEN]) < target, bar);
        __builtin_amdgcn_fence(__ATOMIC_ACQUIRE, "agent");
        asm volatile("s_waitcnt vmcnt(0)" ::: "memory");
    }
    __syncthreads();
}

struct Args { const float* in[20]; float* out; unsigned char* ws; int ph_lo, ph_hi, dry, sub; };
enum { I_X = 0, I_G1, I_WIN, I_CONVW, I_CONVB, I_LNG, I_LNB, I_QG, I_KG, I_LAMQK, I_SUBG, I_RELB, I_WOUT, I_G2, I_RW, I_RB, I_WGU, I_BGU, I_WD, I_BD };

struct Frame {
    LAS unsigned char* lds;
    int tid, lane, wave, vcu, G;
    const float* const* in;
    float* out; unsigned char* ws;
};

template <int MODE>
__device__ __forceinline__ void transpose_item64(const float* W, int K, int N, bf16* WT, int row_off, LAS float* scr, int item, int lane) {
    const int nblk = N / 64, kb = item / nblk, nb = item - kb * nblk, k0 = 64 * kb, n0 = 64 * nb;
    f32x4 v[16];
#pragma unroll
    for (int it = 0; it < 16; ++it) { const int kr = 4 * it + (lane >> 4); v[it] = *(const GAS f32x4*)(W + (size_t)(k0 + kr) * N + n0 + 4 * (lane & 15)); }
#pragma unroll
    for (int it = 0; it < 16; ++it) { const int kr = 4 * it + (lane >> 4); const int col = (4 * (lane & 15) + 8 * (kr >> 3)) & 63; *(LAS f32x4*)(scr + kr * 64 + col) = v[it]; }
    LDS_WAIT(); asm volatile("" ::: "memory");
    const int kc = lane & 7;
#pragma unroll
    for (int jt = 0; jt < 8; ++jt) { const int n = 8 * jt + (lane >> 3); const int col = (n + 8 * kc) & 63; const LAS float* s = scr + (8 * kc) * 64 + col;
        u32x4 o; o.x = pk2(s[0], s[64]); o.y = pk2(s[128], s[192]); o.z = pk2(s[256], s[320]); o.w = pk2(s[384], s[448]);
        int row;
        if (MODE == 0) row = row_off + n0 + n;
        else {
            const int c = n0 + n;
            if (c < 1024) { const int j = c & 511, isg = c >> 9; row = 256 * (j >> 7) + (j & 127) + 128 * isg; }
            else if (c < 2048) { const int cc = c - 1024, t = cc >> 8, w = cc & 255, wc = w >> 6, r = w & 63; row = 1024 + 256 * t + 128 * (r >> 5) + 32 * wc + (r & 31); }
            else row = c;
        }
        *(GAS u32x4*)(WT + (size_t)row * K + k0 + 8 * kc) = o; }
    LDS_WAIT(); asm volatile("" ::: "memory");
}
constexpr int CVT_GU_ITEMS = NE * 512, CVT_ITEMS = NE * 512 + NE * 256;
constexpr int CVT_A = 0, CVT_B = 40, CVT_3 = 76;
static_assert(128 * CVT_A + 128 * CVT_B + 256 * CVT_3 == CVT_ITEMS, "conversion schedule covers every item once");
struct CvtItem { const float* src; unsigned char* dst; int N, mode, n0; };
__device__ __forceinline__ CvtItem cvt_decode(const Frame& F, int id) {
    CvtItem c;
    if (id < CVT_GU_ITEMS) { const int e = id >> 9, q = id & 511, kb = q >> 6, nb = q & 63; c.N = 2 * DFF; c.mode = 1; c.n0 = 32 * nb;
        c.src = F.in[I_WGU] + (size_t)e * DM * 2 * DFF + (size_t)(128 * kb) * (2 * DFF) + 32 * nb; c.dst = F.ws + WS_WGU + (size_t)e * 2 * DFF * DM + 32768 * kb; }
    else if (id >= CVT_ITEMS) { const int q = id - CVT_ITEMS, kb = q / 80, nb = q - kb * 80; c.N = DIN; c.mode = 2; c.n0 = 32 * nb;
        c.src = F.in[I_WIN] + (size_t)(128 * kb) * DIN + 32 * nb; c.dst = F.ws + WS_WIN + (nb < 64 ? 32768 * kb : 2 * MiB + 128 * kb); }
    else { const int r = id - CVT_GU_ITEMS, e = r >> 8, q = r & 255, kb = q >> 5, nb = q & 31; c.N = DM; c.mode = 0; c.n0 = 32 * nb;
        c.src = F.in[I_WD] + (size_t)e * DFF * DM + (size_t)(128 * kb) * DM + 32 * nb; c.dst = F.ws + WS_WD + (size_t)e * DM * DFF + 32768 * kb; }
    return c;
}
__device__ __forceinline__ void cvt_load(f32x4 (&v)[16], const CvtItem& c, int lane) {
#pragma unroll
    for (int it = 0; it < 16; ++it) { const int kr = 16 * (lane >> 3) + it; v[it] = __builtin_nontemporal_load((const GAS f32x4*)(c.src + (size_t)kr * c.N + 4 * (lane & 7))); }
}
__device__ __forceinline__ void cvt_finish(const f32x4 (&v)[16], const CvtItem& c, LAS float* scr, int lane) {
    const int kc = lane >> 3;
#pragma unroll
    for (int jt = 0; jt < 4; ++jt) { const int n = 4 * (lane & 7) + jt;
        u32x4 o;
#pragma unroll
        for (int q = 0; q < 4; ++q) o[q] = pk4_fp8(v[4 * q][jt] * W8_SCALE, v[4 * q + 1][jt] * W8_SCALE, v[4 * q + 2][jt] * W8_SCALE, v[4 * q + 3][jt] * W8_SCALE);
        const int cc = c.n0 + n; int row = (cc & ~255) | (((cc >> 3) & 1) << 7) | (((cc >> 4) & 15) << 3) | (cc & 7);
        if (c.mode == 1) { const int j = cc >> 1; row = (j >> 7) * 256 + (j & 127) + 128 * (cc & 1); }
        if (c.mode == 2) {
            if (cc < 1024) { const int j = cc & 511, isg = cc >> 9; row = 256 * (j >> 7) + (j & 127) + 128 * isg; }
            else if (cc < 2048) { const int c2 = cc - 1024, t = c2 >> 8, w = c2 & 255, wc = w >> 6, r = w & 63; row = 1024 + 256 * t + 128 * (r >> 5) + 32 * wc + (r & 31); }
            else { __builtin_nontemporal_store(o, (GAS u32x4*)(c.dst + (size_t)(cc - 2048) * DM + 16 * kc)); continue; }
        }
        __builtin_nontemporal_store(o, (GAS u32x4*)(c.dst + (size_t)(row >> 8) * 262144 + ((row >> 7) & 1) * 16384 + (row & 127) * 128 + 16 * kc)); }
}
__device__ __forceinline__ void convert_items(Frame& F, int first, int count) {
    LAS float* scr = (LAS float*)(F.lds + F.wave * 16384);
    const int end = first + count; int it = first + F.wave;
    f32x4 va[16], vb[16]; CvtItem ca, cb;
    if (it < end) { ca = cvt_decode(F, it); cvt_load(va, ca, F.lane); }
    for (; it < end; it += 16) {
        if (it + 8 < end) { cb = cvt_decode(F, it + 8); cvt_load(vb, cb, F.lane); }
        cvt_finish(va, ca, scr, F.lane);
        if (it + 16 < end) { ca = cvt_decode(F, it + 16); cvt_load(va, ca, F.lane); }
        if (it + 8 < end) cvt_finish(vb, cb, scr, F.lane);
    }
}
__device__ __forceinline__ void rms_row_to_bf16(int lane, const float* xrow, const float* g, bf16* orow) {
    const GAS f32x4* xr = (const GAS f32x4*)xrow + lane;
    f32x4 v[4]; float s = 0.f;
#pragma unroll
    for (int j = 0; j < 4; ++j) { v[j] = xr[64 * j]; s += (v[j].x * v[j].x + v[j].y * v[j].y) + (v[j].z * v[j].z + v[j].w * v[j].w); }
    const float rstd = 1.0f / sqrtf(wave_sum(s) * (1.f / DM) + EPS);
    GAS u32x2* o8 = (GAS u32x2*)orow + lane;
#pragma unroll
    for (int j = 0; j < 4; ++j) { const f32x4 gg = *((const GAS f32x4*)g + lane + 64 * j); u32x2 w; w.x = pk2(v[j].x * rstd * gg.x, v[j].y * rstd * gg.y); w.y = pk2(v[j].z * rstd * gg.z, v[j].w * rstd * gg.w); o8[64 * j] = w; }
}

__device__ __forceinline__ void rms_row_to_fp8(int lane, const float* xrow, const float* g, unsigned char* orow) {
    const GAS f32x4* xr = (const GAS f32x4*)xrow + lane;
    f32x4 v[4]; float s = 0.f;
#pragma unroll
    for (int j = 0; j < 4; ++j) { v[j] = xr[64 * j]; s += (v[j].x * v[j].x + v[j].y * v[j].y) + (v[j].z * v[j].z + v[j].w * v[j].w); }
    const float rstd = 1.0f / sqrtf(wave_sum(s) * (1.f / DM) + EPS);
    GAS unsigned* o4 = (GAS unsigned*)orow + lane;
#pragma unroll
    for (int j = 0; j < 4; ++j) { const f32x4 gg = *((const GAS f32x4*)g + lane + 64 * j); o4[64 * j] = pk4_fp8(v[j].x * rstd * gg.x, v[j].y * rstd * gg.y, v[j].z * rstd * gg.z, v[j].w * rstd * gg.w); }
}

__device__ __forceinline__ void p0_prologue(Frame& F, bool cvt_all) {
    LAS float* scr = (LAS float*)(F.lds + F.wave * 16384);
    const int gw = F.vcu * NWAVES + F.wave, NGW = F.G * NWAVES;
    constexpr int I_IN = (DM / 64) * (DIN / 64), I_OUT = (DM / 64) * (DM / 64);
    constexpr int NITEMS = I_OUT;
    bf16* Win_t = (bf16*)(F.ws + WS_WIN); bf16* Wout_t = (bf16*)(F.ws + WS_WOUT);
    for (int it = gw; it < NITEMS; it += NGW) {
        int r = it;
        transpose_item64<0>(F.in[I_WOUT], DM, DM, Wout_t, 0, scr, r, F.lane);
    }
    {
        f32x4 va[16];
        for (int it = gw; it < 640; it += NGW) { const CvtItem ci = cvt_decode(F, CVT_ITEMS + it); cvt_load(va, ci, F.lane); cvt_finish(va, ci, scr, F.lane); }
    }
    if (cvt_all) { const int per = (CVT_ITEMS + F.G - 1) / F.G, f0 = F.vcu * per; int n = CVT_ITEMS - f0; n = n < per ? n : per; if (n > 0) convert_items(F, f0, n); }
    {
        bf16* wrt = (bf16*)(F.ws + WS_WRT);
        for (int i = F.vcu * (NWAVES * 64) + F.tid; i < DM * NE; i += F.G * NWAVES * 64) {
            const int k = i >> 5, e = i & 31; const float w = F.in[I_RW][i] * F.in[I_G2][k];
            const unsigned hb = f2bf(w); const float hf = __builtin_bit_cast(float, hb << 16);
            wrt[e * DM + k] = (bf16)hb; wrt[NE * DM + e * DM + k] = (bf16)f2bf(w - hf);
        }
    }
    unsigned char* XN = F.ws + WS_XN;
    {
        const GAS f32x4* gp = (const GAS f32x4*)F.in[I_G1] + F.lane;
        const f32x4 g0 = gp[0], g1 = gp[64], g2 = gp[128], g3 = gp[192];
        for (int m = gw; m < NTOK; m += 4 * NGW) {
            f32x4 v[4][4];
#pragma unroll
            for (int r = 0; r < 4; ++r) { const int row = m + r * NGW; const GAS f32x4* xr = (const GAS f32x4*)(F.in[I_X] + (size_t)(row < NTOK ? row : m) * DM) + F.lane;
#pragma unroll
                for (int j = 0; j < 4; ++j) v[r][j] = xr[64 * j]; }
#pragma unroll
            for (int r = 0; r < 4; ++r) { const int row = m + r * NGW;
                float ss = 0.f;
#pragma unroll
                for (int j = 0; j < 4; ++j) ss += (v[r][j].x * v[r][j].x + v[r][j].y * v[r][j].y) + (v[r][j].z * v[r][j].z + v[r][j].w * v[r][j].w);
                const float rstd = 1.0f / sqrtf(wave_sum(ss) * (1.f / DM) + EPS);
                if (row < NTOK) { GAS unsigned* o4 = (GAS unsigned*)(XN + (size_t)row * DM) + F.lane;
                    const f32x4 a0 = v[r][0] * g0 * rstd, a1 = v[r][1] * g1 * rstd, a2 = v[r][2] * g2 * rstd, a3 = v[r][3] * g3 * rstd;
                    o4[0] = pk4_fp8(a0.x, a0.y, a0.z, a0.w); o4[64] = pk4_fp8(a1.x, a1.y, a1.z, a1.w); o4[128] = pk4_fp8(a2.x, a2.y, a2.z, a2.w); o4[192] = pk4_fp8(a3.x, a3.y, a3.z, a3.w); }
            }
        }
    }
}

__device__ __forceinline__ void p3_conv(Frame& F) {
    const bf16* U = (const bf16*)(F.ws + WS_U); bf16* mixed = (bf16*)(F.ws + WS_MIX);
    LAS bf16* ubuf = (LAS bf16*)F.lds;
    LAS float* ybuf = (LAS float*)(F.lds + 98304);
    LAS float* stt = ybuf + 16 * DCONV;
    const int c = F.tid;
    f32x2 cwA[15], cwB[15];
#pragma unroll
    for (int j = 0; j < 15; ++j) { const float w0 = F.in[I_CONVW][(2 * j) * DCONV + c], w1 = F.in[I_CONVW][(2 * j + 1) * DCONV + c], w2 = F.in[I_CONVW][(2 * j + 2) * DCONV + c];
        cwA[j] = (f32x2){w0, w1}; cwB[j] = (f32x2){w1, w2}; }
    const float cw0 = F.in[I_CONVW][c], cw30 = F.in[I_CONVW][30 * DCONV + c];
    const float cb = F.in[I_CONVB][c], lg = F.in[I_LNG][c], lb = F.in[I_LNB][c];
    for (int tile = F.vcu; tile < NTOK / 64; tile += F.G) {
        const int b = tile / (SEQ / 64), t0 = (tile % (SEQ / 64)) * 64;
        __syncthreads();
        {
            u32x4 uv[12];
#pragma unroll
            for (int k = 0; k < 12; ++k) {
                const int it = F.tid + k * (NWAVES * 64); const int row = it >> 6, ch = (it & 63) * 8; int tt = t0 - 30 + row; tt = tt < 0 ? 0 : tt;
                if (it < 94 * 64) uv[k] = *(const GAS u32x4*)(U + (size_t)(b * SEQ + tt) * DCONV + ch);
            }
#pragma unroll
            for (int k = 0; k < 12; ++k) {
                const int it = F.tid + k * (NWAVES * 64); const int row = it >> 6, ch = (it & 63) * 8; const bool live = (t0 - 30 + row) >= 0;
                if (it < 94 * 64) *(LAS u32x4*)(ubuf + row * DCONV + ch) = live ? uv[k] : (u32x4){0u, 0u, 0u, 0u};
            }
        }
        LDS_WAIT(); __syncthreads();
        f32x2 win2[23];
#pragma unroll
        for (int j = 0; j < 15; ++j) win2[j] = (f32x2){bf2f(ubuf[(2 * j) * DCONV + c]), bf2f(ubuf[(2 * j + 1) * DCONV + c])};
        bf16* orow = mixed + (size_t)(b * SEQ + t0) * DM + c;
#pragma unroll 1
        for (int o16 = 0; o16 < 4; ++o16) {
            float y[16];
#pragma unroll
            for (int q = 0; q < 8; ++q) win2[15 + q] = (f32x2){bf2f(ubuf[(30 + o16 * 16 + 2 * q) * DCONV + c]), bf2f(ubuf[(31 + o16 * 16 + 2 * q) * DCONV + c])};
#pragma unroll
            for (int q = 0; q < 16; ++q) {
                f32x2 a2 = (f32x2){cb, 0.f};
                if ((q & 1) == 0) {
#pragma unroll
                    for (int j = 0; j < 15; ++j) a2 += cwA[j] * win2[(q >> 1) + j];
                    y[q] = (a2.x + a2.y) + cw30 * win2[(q >> 1) + 15].x;
                } else {
#pragma unroll
                    for (int j = 0; j < 15; ++j) a2 += cwB[j] * win2[((q + 1) >> 1) + j];
                    y[q] = (a2.x + a2.y) + cw0 * win2[q >> 1].y;
                }
            }
#pragma unroll
            for (int q = 0; q < 16; ++q) ybuf[q * DCONV + c] = y[q];
            LDS_WAIT(); __syncthreads();
#pragma unroll
            for (int t2 = 0; t2 < 2; ++t2) {
                const int tk = F.wave * 2 + t2;
                const f32x4 v0 = *(const LAS f32x4*)(ybuf + tk * DCONV + F.lane * 8), v1 = *(const LAS f32x4*)(ybuf + tk * DCONV + F.lane * 8 + 4);
                const float sm = wave_sum((v0.x + v0.y) + (v0.z + v0.w) + (v1.x + v1.y) + (v1.z + v1.w));
                const float sq = wave_sum((v0.x * v0.x + v0.y * v0.y) + (v0.z * v0.z + v0.w * v0.w) + (v1.x * v1.x + v1.y * v1.y) + (v1.z * v1.z + v1.w * v1.w));
                const float mean = sm * (1.0f / DCONV), var = fmaxf(sq * (1.0f / DCONV) - mean * mean, 0.f);
                if (F.lane == 0) { stt[tk * 2] = mean; stt[tk * 2 + 1] = 1.0f / sqrtf(var + EPS); }
            }
            LDS_WAIT(); __syncthreads();
            f32x4 sv[8];
#pragma unroll
            for (int i = 0; i < 8; ++i) sv[i] = *(const LAS f32x4*)(stt + 4 * i);
#pragma unroll
            for (int q = 0; q < 16; ++q) {
                const float mean = sv[q >> 1][(q & 1) * 2], rstd = sv[q >> 1][(q & 1) * 2 + 1];
                const float z = (y[q] - mean) * rstd * lg + lb;
                const float o = z * __builtin_amdgcn_rcpf(1.0f + __builtin_amdgcn_exp2f(-LOG2E * z));
                orow[(size_t)(o16 * 16 + q) * DM] = (bf16)f2bf(o);
            }
#pragma unroll
            for (int j = 0; j < 15; ++j) win2[j] = win2[j + 8];
        }
    }
}

__device__ __forceinline__ int t5_bucket(int rel) {
    const int n = rel < 0 ? -rel : rel; int bkt;
    if (n < 8) bkt = n; else { const int k = 31 - __builtin_clz((unsigned)(n * n) >> 6); bkt = 8 + k; if (bkt > 15) bkt = 15; }
    return bkt + (rel > 0 ? 16 : 0);
}
constexpr int AT_STAGE = 32768;
__device__ __forceinline__ int swap23(int r) { return (r & ~12) | ((r & 4) << 1) | ((r & 8) >> 1); }

__device__ __forceinline__ void attn_unit2(Frame& F, int b, int h, int qb, float lam, float bsh) {
    const bf16* QK = (const bf16*)(F.ws + WS_QK); const bf16* Vt = (const bf16*)(F.ws + WS_VT); bf16* mixed = (bf16*)(F.ws + WS_MIX);
    const int lane = F.lane, wid = F.wave, m = wid >> 2, grp = (wid ^ (wid >> 2)) & 1, rg = 2 * grp + ((wid >> 1) & 1), r32 = lane & 31, hi = lane >> 5;
    const int qrow = qb * 128 + 32 * rg + r32, cq = 2 * qb + (rg >> 1), ntile = 2 * qb + 2;
    LAS unsigned char* lds = F.lds;
    const LAS float* lut = (const LAS float*)(F.lds + LDSX_OFF);
    bf16x8 qf[4];
    { const bf16* qp = QK + (size_t)(b * SEQ + qrow) * DM + h * 128 + m * 64 + hi * 8;
#pragma unroll
      for (int d0 = 0; d0 < 4; ++d0) qf[d0] = *(const GAS bf16x8*)(qp + d0 * 16); }
    const int rho = 8 * wid + (lane >> 3), cpos = lane & 7;
    const bf16* ksrc = QK + (size_t)(b * SEQ + swap23(rho)) * DM + 512 + h * 128 + ((cpos ^ ((rho >> 1) & 7)) << 3);
    const bf16* vsrc = Vt + (size_t)((b * NH + h) * DV + rho) * SEQ + ((cpos ^ ((rho >> 1) & 7)) << 3);
    const unsigned ldsw = (unsigned)wid * 1024u;
#define AT_DMA(j, st) do { LAS unsigned char* sb_ = lds + (st) * AT_STAGE + ldsw; \
        __builtin_amdgcn_global_load_lds((const unsigned*)(ksrc + (size_t)(j) * 64 * DM), (LAS unsigned*)(sb_), 16, 0, 0); \
        __builtin_amdgcn_global_load_lds((const unsigned*)(ksrc + (size_t)(j) * 64 * DM + 64), (LAS unsigned*)(sb_ + 8192), 16, 0, 0); \
        __builtin_amdgcn_global_load_lds((const unsigned*)(vsrc + (j) * 64), (LAS unsigned*)(sb_ + 16384), 16, 0, 0); \
        __builtin_amdgcn_global_load_lds((const unsigned*)(vsrc + (size_t)64 * SEQ + (j) * 64), (LAS unsigned*)(sb_ + 24576), 16, 0, 0); } while (0)
    const int swz = (r32 >> 1) & 7;
    unsigned foff[4];
#pragma unroll
    for (int s = 0; s < 4; ++s) foff[s] = (unsigned)(r32 * 128 + (((2 * s + hi) ^ swz) << 4));
    f32x16 o[4];
#pragma unroll
    for (int i = 0; i < 4; ++i)
#pragma unroll
        for (int r = 0; r < 16; ++r) o[i][r] = 0.f;
    float lrun = 0.f, lrun2 = 0.f;
    const float c15 = lut[0];
    f32x16 c15v;
#pragma unroll
    for (int r = 0; r < 16; ++r) c15v[r] = c15;
    asm volatile("" : "+v"(c15v));
    bf16x8 pfA[4];
    f32x16 sa[2];
#define AT_QK(j) do { const LAS unsigned char* kb = lds + ((j) & 3) * AT_STAGE + m * 8192; \
        if (cq - (j) >= 3) {   \
            _Pragma("unroll") for (int hh = 0; hh < 2; ++hh) { const bf16x8 kf = *(const LAS bf16x8*)(kb + hh * 4096 + foff[0]); sa[hh] = __builtin_amdgcn_mfma_f32_32x32x16_bf16(kf, qf[0], c15v, 0, 0, 0); } \
        } else { const int bi = 64 * ((j) - cq) + 8 * hi - 32 * (rg & 1) - r32 + 191; \
            _Pragma("unroll") for (int hh = 0; hh < 2; ++hh) _Pragma("unroll") for (int r = 0; r < 16; ++r) sa[hh][r] = lut[bi + 32 * hh + 16 * (r >> 3) + (r & 7)]; \
            _Pragma("unroll") for (int hh = 0; hh < 2; ++hh) { const bf16x8 kf = *(const LAS bf16x8*)(kb + hh * 4096 + foff[0]); sa[hh] = __builtin_amdgcn_mfma_f32_32x32x16_bf16(kf, qf[0], sa[hh], 0, 0, 0); } } \
        _Pragma("unroll") for (int d0 = 1; d0 < 4; ++d0) _Pragma("unroll") for (int hh = 0; hh < 2; ++hh) { const bf16x8 kf = *(const LAS bf16x8*)(kb + hh * 4096 + foff[d0]); sa[hh] = __builtin_amdgcn_mfma_f32_32x32x16_bf16(kf, qf[d0], sa[hh], 0, 0, 0); } } while (0)
#define AT_SM1(PW, s_) do { u32x4 pw; _Pragma("unroll") for (int i = 0; i < 4; ++i) { \
            const float p0 = __builtin_amdgcn_exp2f(sa[(s_) >> 1][8 * ((s_) & 1) + 2 * i]), p1 = __builtin_amdgcn_exp2f(sa[(s_) >> 1][8 * ((s_) & 1) + 2 * i + 1]); \
            lrun += p0; lrun2 += p1; pw[i] = pk2c(p0, p1); } PW[s_] = __builtin_bit_cast(bf16x8, pw); } while (0)
#define AT_SM(PW) do { AT_SM1(PW, 0); AT_SM1(PW, 1); AT_SM1(PW, 2); AT_SM1(PW, 3); } while (0)
#define AT_PV1(j, PR, s_) do { const LAS unsigned char* vb = lds + ((j) & 3) * AT_STAGE + 16384; \
        _Pragma("unroll") for (int db = 0; db < 4; ++db) { const bf16x8 vf = *(const LAS bf16x8*)(vb + db * 4096 + foff[s_]); o[db] = __builtin_amdgcn_mfma_f32_32x32x16_bf16(vf, PR[s_], o[db], 0, 0, 0); } } while (0)
#define AT_PV(j, PR) do { AT_PV1(j, PR, 0); AT_PV1(j, PR, 1); AT_PV1(j, PR, 2); AT_PV1(j, PR, 3); } while (0)
#define AT_SB __builtin_amdgcn_sched_barrier(0)
#define AT_PVSM(j, PR, PW) do { AT_SB; AT_PV1((j) - 1, PR, 0); AT_SM1(PW, 0); AT_SB; AT_PV1((j) - 1, PR, 1); AT_SM1(PW, 1); AT_SB; AT_PV1((j) - 1, PR, 2); AT_SM1(PW, 2); AT_SB; AT_PV1((j) - 1, PR, 3); AT_SM1(PW, 3); AT_SB; } while (0)
#define AT_TOP(j) do { asm volatile("s_waitcnt vmcnt(4)" ::: "memory"); __builtin_amdgcn_s_barrier(); \
        { const int jn = ((j) + 2 < ntile) ? (j) + 2 : 0; AT_DMA(jn, ((j) + 2) & 3); } } while (0)
    AT_DMA(0, 0); AT_DMA(1, 1);
    const int jend = grp == 0 ? ntile - 1 : ntile;
    AT_TOP(0); AT_QK(0); AT_SM(pfA);
    for (int j = 1; j < jend; ++j) { AT_TOP(j); AT_QK(j); AT_PVSM(j, pfA, pfA); }
    if (grp == 0) AT_TOP(ntile - 1);
    AT_PV(jend - 1, pfA);
#undef AT_QK
#undef AT_SM1
#undef AT_SM
#undef AT_PV1
#undef AT_PV
#undef AT_PVSM
#undef AT_SB
#undef AT_TOP
#undef AT_DMA
    asm volatile("s_waitcnt vmcnt(0)" ::: "memory");
    __builtin_amdgcn_s_barrier();
    lrun += lrun2;
    const float ltot = lrun + __shfl_xor(lrun, 32);
    const float inv = 1.0f / ltot;
    LAS float* xb = (LAS float*)lds + rg * 4096;
    if (m == 1) {
        const float f = inv * lam;
#pragma unroll
        for (int db = 0; db < 4; ++db)
#pragma unroll
            for (int r = 0; r < 16; ++r) xb[(db * 16 + r) * 64 + lane] = o[db][r] * f;
    }
    LDS_WAIT(); __builtin_amdgcn_s_barrier(); asm volatile("" ::: "memory");
    if (m == 0) {
        float ss = 0.f;
#pragma unroll
        for (int db = 0; db < 4; ++db)
#pragma unroll
            for (int r = 0; r < 16; ++r) { const float d = o[db][r] * inv - xb[(db * 16 + r) * 64 + lane]; o[db][r] = d; ss += d * d; }
        ss += __shfl_xor(ss, 32);
        const float rstd = 0.8f / sqrtf(ss * (1.0f / DV) + EPS);
        bf16* orow = mixed + (size_t)(b * SEQ + qrow) * DM + DCONV + h * DV;
        const LAS float* sg = lut + 256;
#pragma unroll
        for (int db = 0; db < 4; ++db)
#pragma unroll
            for (int r4 = 0; r4 < 4; ++r4) {
                const int d = 32 * db + 8 * r4 + 4 * hi;
                const f32x4 g = *(const LAS f32x4*)(sg + d);
                u32x2 w; w.x = pk2(o[db][4 * r4] * rstd * g.x, o[db][4 * r4 + 1] * rstd * g.y); w.y = pk2(o[db][4 * r4 + 2] * rstd * g.z, o[db][4 * r4 + 3] * rstd * g.w);
                *(GAS u32x2*)(orow + d) = w;
            }
    }
    LDS_WAIT(); __builtin_amdgcn_s_barrier(); asm volatile("" ::: "memory");
}

__device__ __forceinline__ void p3_attn(Frame& F, int part) {
    float lam, bsh;
    { const float* lq = F.in[I_LAMQK]; const float a = lq[F.lane] * lq[64 + F.lane], c = lq[128 + F.lane] * lq[192 + F.lane];
      lam = __expf(wave_sum(a)) - __expf(wave_sum(c)) + 0.2f;
      float mq = fmaxf(fabsf(F.in[I_QG][F.lane]), fabsf(F.in[I_QG][64 + F.lane])), mk = fmaxf(fabsf(F.in[I_KG][F.lane]), fabsf(F.in[I_KG][64 + F.lane]));
      float mb = fabsf(F.in[I_RELB][F.lane]); mb = fmaxf(mb, fabsf(F.in[I_RELB][64 + F.lane]));
#pragma unroll
      for (int o = 1; o < 64; o <<= 1) { mq = fmaxf(mq, __shfl_xor(mq, o)); mk = fmaxf(mk, __shfl_xor(mk, o)); mb = fmaxf(mb, __shfl_xor(mb, o)); }
      bsh = 64.0f * 0.125f * LOG2E * mq * mk * 1.02f + mb * LOG2E + 0.5f; }
    LAS float* lut = (LAS float*)(F.lds + LDSX_OFF);
    for (int u = F.vcu; u < 256; u += F.G) {
        const int bh = u >> 3, s = u & 7, b = bh >> 2, h = bh & 3;
        __syncthreads();
        if (F.tid < 256) { const int rel = F.tid - 191; lut[F.tid] = F.in[I_RELB][t5_bucket(rel) * NH + h] * LOG2E - bsh; }
        else if (F.tid < 256 + DV) lut[F.tid] = F.in[I_SUBG][F.tid - 256];
        LDS_WAIT(); __syncthreads();
        attn_unit2(F, b, h, part ? 15 - s : s, lam, bsh);
    }
}

__device__ __forceinline__ int crow32(int r, int hi) { return (r & 3) + 8 * (r >> 2) + 4 * hi; }
template <bool DRY = false>
__device__ __forceinline__ void p5_router(Frame& F) {
    const bf16* hsrc = (const bf16*)(F.ws + WS_XN); unsigned char* HN = F.ws + (DRY ? 700 * MiB : WS_HN8);
    int* list = (int*)(F.ws + (DRY ? 720 * MiB : WS_LIST)); float* gates = (float*)(F.ws + (DRY ? 724 * MiB : WS_GATES));
    unsigned* cnt = (unsigned*)(F.ws + WS_CTL) + (DRY ? CW_CNT + 2048 : CW_CNT);
    LAS float* part = (LAS float*)F.lds;
    LAS float* ssq = (LAS float*)(F.lds + 65536);
    LAS float* rstdl = ssq + 512;
    LAS int* hist = (LAS int*)(F.lds + LDSX_OFF);
    LAS int* basel = hist + 32;
    LAS int* pendE = hist + 64;
    LAS float* pendG = (LAS float*)(hist + 320);
    const int lane = F.lane, wid = F.wave, r32 = lane & 31, hi5 = lane >> 5, kbase = wid * 128;
    bf16x8 bh[8], bl[8];
    { const bf16* wh = (const bf16*)(F.ws + WS_WRT) + r32 * DM + kbase + 8 * hi5;
#pragma unroll
      for (int ks = 0; ks < 8; ++ks) { bh[ks] = *(const GAS bf16x8*)(wh + 16 * ks); bl[ks] = *(const GAS bf16x8*)(wh + NE * DM + 16 * ks); } }
    const float rb = F.in[I_RB][r32];
    for (int tile = F.vcu; tile < NTOK / 64; tile += F.G) {
        const int tok0 = tile * 64;
        __syncthreads();
        if (F.tid < 32) hist[F.tid] = 0;
#pragma unroll
        for (int tt = 0; tt < 2; ++tt) {
            const bf16* hp = hsrc + (size_t)(tok0 + 32 * tt + r32) * DM + kbase + 8 * hi5;
            u32x4 v[8];
#pragma unroll
            for (int ks = 0; ks < 8; ++ks) v[ks] = *(const GAS u32x4*)(hp + 16 * ks);
            f32x16 acc;
#pragma unroll
            for (int r = 0; r < 16; ++r) acc[r] = 0.f;
            float ss = 0.f;
#pragma unroll
            for (int ks = 0; ks < 8; ++ks) {
#pragma unroll
                for (int i = 0; i < 4; ++i) { const float x0 = bflo(v[ks][i]), x1 = bfhi(v[ks][i]); ss += x0 * x0 + x1 * x1; }
                const bf16x8 ah = __builtin_bit_cast(bf16x8, v[ks]);
                acc = __builtin_amdgcn_mfma_f32_32x32x16_bf16(ah, bh[ks], acc, 0, 0, 0);
                acc = __builtin_amdgcn_mfma_f32_32x32x16_bf16(ah, bl[ks], acc, 0, 0, 0);
            }
            LAS float* pp = part + (tt * 8 + wid) * 1024;
#pragma unroll
            for (int r = 0; r < 16; ++r) pp[crow32(r, hi5) * 32 + r32] = acc[r];
            ss += __shfl_xor(ss, 32);
            if (lane < 32) ssq[(tt * 8 + wid) * 32 + lane] = ss;
        }
        LDS_WAIT(); __syncthreads();
#pragma unroll
        for (int tt = 0; tt < 2; ++tt)
#pragma unroll
            for (int rr = 0; rr < 2; ++rr) {
                const int tl = 4 * wid + 2 * rr + hi5, el = r32;
                float lg = 0.f, sq = 0.f;
#pragma unroll
                for (int w = 0; w < 8; ++w) { lg += part[((tt * 8 + w) * 32 + tl) * 32 + el]; sq += ssq[(tt * 8 + w) * 32 + tl]; }
                const float rstd = 1.0f / sqrtf(sq * (1.0f / DM) + EPS);
                if (el == 0) rstdl[tt * 32 + tl] = rstd;
                float v = lg * rstd + rb;
                float topv[4]; int topi[4];
#pragma unroll
                for (int k = 0; k < 4; ++k) {
                    float bv = v;
                    bv = fmaxf(bv, __builtin_bit_cast(float, __builtin_amdgcn_update_dpp(0, __builtin_bit_cast(int, bv), 0xB1, 0xF, 0xF, true)));
                    bv = fmaxf(bv, __builtin_bit_cast(float, __builtin_amdgcn_update_dpp(0, __builtin_bit_cast(int, bv), 0x4E, 0xF, 0xF, true)));
                    bv = fmaxf(bv, __builtin_bit_cast(float, __builtin_amdgcn_update_dpp(0, __builtin_bit_cast(int, bv), 0x141, 0xF, 0xF, true)));
                    bv = fmaxf(bv, __builtin_bit_cast(float, __builtin_amdgcn_update_dpp(0, __builtin_bit_cast(int, bv), 0x140, 0xF, 0xF, true)));
                    bv = fmaxf(bv, __shfl_xor(bv, 16));
                    const unsigned long long eqm = __ballot(v == bv);
                    const unsigned half = hi5 ? (unsigned)(eqm >> 32) : (unsigned)eqm;
                    const int bi = __builtin_ctz(half);
                    topv[k] = bv; topi[k] = bi; if (el == bi) v = -INFINITY;
                }
                const float e1 = __expf(topv[1] - topv[0]), e2 = __expf(topv[2] - topv[0]), e3 = __expf(topv[3] - topv[0]);
                const float inv = 1.0f / (1.0f + e1 + e2 + e3);
                if (el < 4) {
                    const int ee = el == 0 ? topi[0] : el == 1 ? topi[1] : el == 2 ? topi[2] : topi[3];
                    const float gg = (el == 0 ? 1.0f : el == 1 ? e1 : el == 2 ? e2 : e3) * inv;
                    const int slot = atomicAdd((int*)&hist[ee], 1);
                    const int idx = (tt * 32 + tl) * 4 + el;
                    pendE[idx] = ee | (slot << 8); pendG[idx] = gg;
                }
            }
        LDS_WAIT(); __syncthreads();
        if (F.tid < 32) basel[F.tid] = (int)__hip_atomic_fetch_add(cnt + 32 * F.tid, (unsigned)hist[F.tid], RLX_AGENT);
        {
            f32x4 gq[4];
#pragma unroll
            for (int q = 0; q < 4; ++q) gq[q] = *((const GAS f32x4*)F.in[I_G2] + lane * 4 + q);
#pragma unroll
            for (int jb = 0; jb < 2; ++jb) {
                u32x4 hx[4][2];
#pragma unroll
                for (int j = 0; j < 4; ++j) { const GAS u32x4* xr = (const GAS u32x4*)(hsrc + (size_t)(tok0 + wid * 8 + jb * 4 + j) * DM) + lane * 2; hx[j][0] = xr[0]; hx[j][1] = xr[1]; }
#pragma unroll
                for (int j = 0; j < 4; ++j) { const int tl = wid * 8 + jb * 4 + j; const float rstd = rstdl[tl];
                    u32x4 o;
#pragma unroll
                    for (int q = 0; q < 4; ++q) { const unsigned w0 = hx[j][q >> 1][(q & 1) * 2], w1 = hx[j][q >> 1][(q & 1) * 2 + 1];
                        o[q] = pk4_fp8(bflo(w0) * rstd * gq[q].x, bfhi(w0) * rstd * gq[q].y, bflo(w1) * rstd * gq[q].z, bfhi(w1) * rstd * gq[q].w); }
                    st16_sc1((unsigned char*)HN + (size_t)(tok0 + tl) * DM + lane * 16, o); }
            }
        }
        LDS_WAIT(); __syncthreads();
        if (F.tid < 256) {
            const int pe = pendE[F.tid], ee = pe & 0xff, slot = pe >> 8; const int entry = (tok0 + (F.tid >> 2)) * 4 + (F.tid & 3);
            const int gs = basel[ee] + slot;
            list[ee * LIST_CAP + gs] = entry; gates[entry] = pendG[F.tid]; ((unsigned*)gates)[NTOK * TOPK + entry] = ((unsigned)ee << 16) | (unsigned)gs;
        }
    }
}

template <bool DRY = false>
__device__ __forceinline__ void p8_combine(Frame& F, int pre_lane) {
    const unsigned char* yb = F.ws + WS_YB; float* dout = DRY ? (float*)(F.ws + 700 * MiB) : F.out;
    const float* gates = (const float*)(F.ws + WS_GATES); const unsigned* eslot = (const unsigned*)(F.ws + WS_GATES) + NTOK * TOPK;
    LAS int* rbx = (LAS int*)(F.lds + LDSX_OFF);
    __syncthreads();
    if (F.tid < 32) { const int incl = pre_lane; const int prev = __shfl_up(incl, 1); rbx[F.tid] = F.tid ? prev : 0; }
    LDS_WAIT(); __syncthreads();
    const int gt = F.vcu * (NWAVES * 64) + F.tid, NGT = F.G * NWAVES * 64;
    for (int i0 = gt; i0 < NTOK * (DM / 8); i0 += 2 * NGT) {
        int tok[2], c8[2]; u32x4 hw[2], es[2]; f32x4 gv[2]; u32x2 w[2][4]; bool ok[2];
#pragma unroll
        for (int u = 0; u < 2; ++u) { const int i = i0 + u * NGT; ok[u] = i < NTOK * (DM / 8); const int ii = ok[u] ? i : i0; tok[u] = ii >> 7; c8[u] = (ii & 127) * 8;
            hw[u] = *(const GAS u32x4*)((const bf16*)(F.ws + WS_XN) + (size_t)tok[u] * DM + c8[u]);
            es[u] = *(const GAS u32x4*)(eslot + tok[u] * 4); gv[u] = *(const GAS f32x4*)(gates + tok[u] * 4); }
#pragma unroll
        for (int u = 0; u < 2; ++u)
#pragma unroll
            for (int k = 0; k < 4; ++k) { const int row = 256 * rbx[es[u][k] >> 16] + (int)(es[u][k] & 0xffffu); w[u][k] = *(const GAS u32x2*)(yb + (size_t)row * DM + c8[u]); }
#pragma unroll
        for (int u = 0; u < 2; ++u) {
            f32x4 a = (f32x4){bflo(hw[u].x), bfhi(hw[u].x), bflo(hw[u].y), bfhi(hw[u].y)}, b = (f32x4){bflo(hw[u].z), bfhi(hw[u].z), bflo(hw[u].w), bfhi(hw[u].w)};
            f32x4 sa = (f32x4){0.f, 0.f, 0.f, 0.f}, sb = (f32x4){0.f, 0.f, 0.f, 0.f};
#pragma unroll
            for (int k = 0; k < 4; ++k) { const float g = gv[u][k];
                const f32x2 p0 = __builtin_amdgcn_cvt_pk_f32_fp8(w[u][k].x, false), p1 = __builtin_amdgcn_cvt_pk_f32_fp8(w[u][k].x, true), p2 = __builtin_amdgcn_cvt_pk_f32_fp8(w[u][k].y, false), p3 = __builtin_amdgcn_cvt_pk_f32_fp8(w[u][k].y, true);
                sa.x += g * p0.x; sa.y += g * p0.y; sa.z += g * p1.x; sa.w += g * p1.y; sb.x += g * p2.x; sb.y += g * p2.y; sb.z += g * p3.x; sb.w += g * p3.y; }
            a = a + sa * YB_INV; b = b + sb * YB_INV;
            if (ok[u]) { float* op = dout + (size_t)tok[u] * DM + c8[u]; *(GAS f32x4*)op = a; *(GAS f32x4*)(op + 4) = b; }
        }
    }
}

__device__ __forceinline__ void moe_table(Frame& F, int& pre_lane, int& cnt_lane, int& total_rb) {
    const unsigned* cnt = (const unsigned*)(F.ws + WS_CTL) + CW_CNT;
    int c = 0, rbn = 0;
    if (F.lane < 32) { c = (int)__hip_atomic_load(cnt + 32 * F.lane, RLX_AGENT); rbn = (c + 255) >> 8; }
    int p = rbn;
#pragma unroll
    for (int o = 1; o < 32; o <<= 1) { const int t = __shfl_up(p, o); if ((F.lane & 31) >= o) p += t; }
    total_rb = __builtin_amdgcn_readlane(p, 31);
    pre_lane = F.lane < 32 ? p : 0x7fffffff; cnt_lane = c;
}

constexpr int N_PHASES = 9;
__global__ void __launch_bounds__(NWAVES * 64, 2) fwd(Args args) {
    extern __shared__ __attribute__((aligned(16))) unsigned char lds_raw[];
    Frame F;
    F.lds = (LAS unsigned char*)lds_raw;
    F.tid = threadIdx.x; F.lane = F.tid & 63; F.wave = __builtin_amdgcn_readfirstlane(F.tid >> 6);
    F.G = gridDim.x; { const int bx = blockIdx.x; F.vcu = (F.G % 8 == 0) ? (bx % 8) * (F.G / 8) + bx / 8 : bx; }
    F.in = args.in; F.out = args.out; F.ws = args.ws;
    volatile LAS unsigned* MISC = (volatile LAS unsigned*)(F.lds + MISC_OFF);
    for (int u = F.tid; u < (LDS_BYTES - MISC_OFF) / 4; u += NWAVES * 64) MISC[u] = 0u;
    __syncthreads();
    unsigned* ctl = (unsigned*)(F.ws + WS_CTL);
#if MK_ONE_LAUNCH
    XcdBarrier bar = xcd_barrier_post(ctl + CW_BAR, MISC + 8);
#define GRID_BAR() xcd_barrier(bar)
#else
#define GRID_BAR() do { } while (0)
#endif
    const int lo = args.ph_lo, hi = args.ph_hi; const bool dry = args.dry != 0; const int sub = args.sub;
#define IN(k) (lo <= (k) && (k) < hi)
#define BOTH(k) (IN(k) && IN((k) + 1))

    const bool sched256 = (F.G == 256);
    if (IN(0)) { p0_prologue(F, !sched256); if (BOTH(0)) GRID_BAR(); }

    if (IN(1)) {
        const int c = (int)blockIdx.x; const bool typeA = c < 128; const int g3 = (c - 128) % 3;
        const int cfirst = typeA ? c * CVT_A : 128 * CVT_A + (c - 128) * CVT_B, ccount = typeA ? CVT_A : CVT_B;
        if (sched256 && !typeA && g3 == 0) { convert_items(F, cfirst, ccount); __syncthreads(); }
        pg8::DenseSched S; S.init(F.ws + WS_XN, F.ws + WS_WIN, NTOK, 2048, DM / 2, F.G, c);
        pg8::EpiInProj E{(bf16*)(F.ws + WS_U), (bf16*)(F.ws + WS_QK), F.in[I_QG], F.in[I_KG]};
        const bool mid = sched256 && !typeA && g3 == 1;
        S.i0 = 0; S.i1 = mid ? 1 : (1 << 20);
        pg8::gemm_phase<pg8::EpiInProj, pg8::DenseSched, true, true, true>(F.lds, DM / 2, S, E);
        if (mid) { __syncthreads(); convert_items(F, cfirst, ccount); __syncthreads();
            S.i0 = 1; S.i1 = 1 << 20;
            pg8::gemm_phase<pg8::EpiInProj, pg8::DenseSched, true, true, true>(F.lds, DM / 2, S, E); }
        {
            pg8::DenseSched S2; S2.init(F.ws + WS_WIN + 2 * MiB, F.ws + WS_XN, DATT, NTOK, DM / 2, F.G, c);
            pg8::EpiVt E2{(bf16*)(F.ws + WS_VT)};
            pg8::gemm_phase<pg8::EpiVt, pg8::DenseSched, true, true, true, false>(F.lds, DM / 2, S2, E2);
        }
        if (sched256 && (typeA || g3 == 2) && ccount > 0) { __syncthreads(); convert_items(F, cfirst, ccount); }
        if (BOTH(1)) GRID_BAR();
    }
    if (IN(3)) {
        const bool cv = sched256 && sub == 0; const int cfirst = 128 * CVT_A + 128 * CVT_B + F.vcu * CVT_3;
        const int g4 = F.vcu & 3;
        if (cv && g4 == 0) { convert_items(F, cfirst, CVT_3); }
        if (sub != 2) p3_conv(F);
        if (cv && g4 == 1) { convert_items(F, cfirst, CVT_3); }
        if (sub != 1) p3_attn(F, 0);
        if (cv && g4 == 2) { convert_items(F, cfirst, CVT_3); }
        if (sub != 1) p3_attn(F, 1);
        if (cv && g4 == 3) { convert_items(F, cfirst, CVT_3); }
        if (BOTH(3)) GRID_BAR(); }
    if (IN(4)) {
        pg8::DenseSched S; S.init(F.ws + WS_MIX, F.ws + WS_WOUT, NTOK, DM, DM, F.G, (int)blockIdx.x);
        pg8::EpiResBf16 E{F.in[I_X], (bf16*)(F.ws + WS_XN), DM};
        pg8::gemm_phase<pg8::EpiResBf16, pg8::DenseSched, true, true>(F.lds, DM, S, E);
        if (BOTH(4)) GRID_BAR();
    }
    if (IN(5)) { if (dry) p5_router<true>(F); else p5_router<false>(F); if (BOTH(5)) GRID_BAR(); }
    if (IN(6)) {
        int pre, cn, trb; moe_table(F, pre, cn, trb);
        pg8::MoeSched<true> S; S.A = (const char*)(F.ws + WS_HN8); S.Bt = (const char*)(F.ws + WS_WGU); S.list = (const int*)(F.ws + WS_LIST); S.K = DM / 2; S.ncb = 8; S.total = trb * 8;
        S.G = F.G; S.c = (int)blockIdx.x; S.pre_lane = pre; S.cnt_lane = cn; S.estride = (size_t)2 * DFF * DM;
        pg8::EpiSwiglu E{F.ws + WS_ACT, F.in[I_BGU]};
        pg8::gemm_phase<pg8::EpiSwiglu, pg8::MoeSched<true>, true, true, true>(F.lds, DM / 2, S, E);
        {
            const int r6 = S.total % F.G, nidle = F.G - r6;
            if (r6 > 0 && S.c >= r6) {
                const GAS u32x4* wd = (const GAS u32x4*)(F.ws + WS_WD);
                const int n16 = NE * DM * DFF / 16, per0 = (n16 + nidle - 1) / nidle, per = per0 < 16384 ? per0 : 16384, b0 = (S.c - r6) * per; int e0 = b0 + per; e0 = e0 < n16 ? e0 : n16;
                u32x4 x = (u32x4){0u, 0u, 0u, 0u};
#pragma unroll 8
                for (int i = b0 + F.tid; i < e0; i += NWAVES * 64) { const u32x4 v = wd[i]; x.x ^= v.x; x.y ^= v.y; x.z ^= v.z; x.w ^= v.w; }
                if (x.x == 0x9e3779b9u && x.y == 0x7f4a7c15u && x.z == 0x85ebca6bu && x.w == 0xc2b2ae35u) ((unsigned*)(F.ws + WS_CTL))[CW_CNT + 4095] = x.x;
            }
        }
        if (BOTH(6)) GRID_BAR();
    }
    if (IN(7)) {
        int pre, cn, trb; moe_table(F, pre, cn, trb);
        pg8::MoeSched<false> S; S.A = (const char*)(F.ws + WS_ACT); S.Bt = (const char*)(F.ws + WS_WD); S.list = (const int*)(F.ws + WS_LIST); S.K = DFF / 2; S.ncb = 4; S.total = trb * 4;
        S.G = F.G; S.c = (int)blockIdx.x; S.pre_lane = pre; S.cnt_lane = cn; S.estride = (size_t)DM * DFF;
        pg8::EpiDown E{F.ws + WS_YB, F.in[I_BD]};
        pg8::gemm_phase<pg8::EpiDown, pg8::MoeSched<false>, true, true, true>(F.lds, DFF / 2, S, E);
        if (BOTH(7)) GRID_BAR();
    }
    if (IN(8)) { int pre, cn, trb; moe_table(F, pre, cn, trb); if (dry) p8_combine<true>(F, pre); else p8_combine<false>(F, pre); }
#undef IN
#undef BOTH
}

extern "C" void kernel_launch(void* const* d_in, const int* in_sizes, int n_in, void* d_out, int out_size, void* d_ws, size_t ws_size, hipStream_t stream) {
    static int grid = 0;
    if (grid == 0) {
        if (n_in != 20 || in_sizes[0] != NTOK * DM || out_size != NTOK * DM || ws_size < WS_END) { fprintf(stderr, "kernel_launch: unexpected shapes (n_in %d, in0 %d, out %d, ws %zu)\n", n_in, n_in > 0 ? in_sizes[0] : -1, out_size, ws_size); grid = -1; return; }
        int dev = 0, cus = 0, per_cu = 0;
        if (hipGetDevice(&dev) != hipSuccess || hipDeviceGetAttribute(&cus, hipDeviceAttributeMultiprocessorCount, dev) != hipSuccess) { grid = -1; return; }
        if (hipFuncSetAttribute((const void*)fwd, hipFuncAttributeMaxDynamicSharedMemorySize, LDS_BYTES) != hipSuccess) { fprintf(stderr, "kernel_launch: hipFuncSetAttribute failed\n"); grid = -1; return; }
        if (hipOccupancyMaxActiveBlocksPerMultiprocessor(&per_cu, (const void*)fwd, NWAVES * 64, LDS_BYTES) != hipSuccess || per_cu < 1) { fprintf(stderr, "kernel_launch: occupancy query reports %d\n", per_cu); }
        (void)hipGetLastError();
        grid = cus;
    }
    if (grid < 0) return;
    (void)hipMemsetAsync((char*)d_ws + WS_CTL, 0, CTL_ZERO_BYTES, stream);
    Args a{};
    for (int i = 0; i < 20; ++i) a.in[i] = (const float*)d_in[i];
    a.out = (float*)d_out; a.ws = (unsigned char*)d_ws;
#if MK_ONE_LAUNCH
    a.ph_lo = 0; a.ph_hi = N_PHASES;
    hipLaunchKernelGGL(fwd, dim3(grid), dim3(NWAVES * 64), LDS_BYTES, stream, a);
    for (int r = 0; r < PROBE_FULLREP; ++r) { (void)hipMemsetAsync((char*)d_ws + WS_CTL, 0, CTL_ZERO_BYTES, stream); hipLaunchKernelGGL(fwd, dim3(grid), dim3(NWAVES * 64), LDS_BYTES, stream, a); }
#else
    for (int p = 0; p < N_PHASES; ++p) {
        a.ph_lo = p; a.ph_hi = p + 1; a.dry = 0; a.sub = 0;
        hipLaunchKernelGGL(fwd, dim3(grid), dim3(NWAVES * 64), LDS_BYTES, stream, a);
        if (p == PROBE_DUP) { a.dry = (p == 2 || p == 5 || p == 8) ? 1 : 0; a.sub = PROBE_SUB;
            for (int r = 0; r < PROBE_REP; ++r) hipLaunchKernelGGL(fwd, dim3(grid), dim3(NWAVES * 64), LDS_BYTES, stream, a); }
    }
#endif
}
```
